# Optimizing an MI355X kernel written in HIP

```python
import math
import jax, jax.numpy as jnp
from jax import lax
import numpy as np

D_MODEL = 1024
BATCH = 32
SEQ = 256
DEPTH = 1
DEC_BATCH = 2
DEC_SEQ = 2048
PAST_LEN = 256

GRID_W = 64
D_RWKV = 512
D_FNET = D_MODEL - D_RWKV
HEAD_DIM = 64
N_HEADS = D_RWKV // HEAD_DIM
FNET_GROUP = 64
N_FGROUPS = D_FNET // FNET_GROUP
LORA_W = 32
LORA_A = 32
N_DIR = 2
D_SHIFT = 3 * D_RWKV + N_DIR * (LORA_W + LORA_A)
D_IN = D_SHIFT + D_RWKV + 2 * D_FNET
NORM_EPS = 1e-6
GN_EPS = 64e-5
POS_BASE = 10000.0

kernel_name = "hybrid_rwkv7_fnet_diffusion_step"


def _rmsnorm(x, g):
    xf = x.astype(jnp.float32)
    y = xf * lax.rsqrt(jnp.mean(xf * xf, axis=-1, keepdims=True) + NORM_EPS)
    return (y * g.astype(jnp.float32)).astype(x.dtype)


def _centred_shift(p):
    prev = jnp.pad(p[:, :-1], ((0, 0), (1, 0), (0, 0)))
    nxt = jnp.pad(p[:, 1:], ((0, 0), (0, 1), (0, 0)))
    return 0.5 * (prev + nxt)


def _sincos_2d(n_tokens, dtype):
    rows = n_tokens // GRID_W
    pos = jnp.arange(rows * GRID_W)
    row = (pos // GRID_W).astype(jnp.float32)
    col = (pos % GRID_W).astype(jnp.float32)
    quarter = D_MODEL // 4
    freq = jnp.exp(-math.log(POS_BASE) * jnp.arange(quarter, dtype=jnp.float32) / quarter)
    ang_r = row[:, None] * freq
    ang_c = col[:, None] * freq
    emb = jnp.concatenate([jnp.sin(ang_r), jnp.cos(ang_r), jnp.sin(ang_c), jnp.cos(ang_c)], axis=-1)
    return emb.astype(dtype)


def _rwkv7_scan(r, w, k, v, kk, a, s0, reverse):
    def step(S, inp):
        r_t, w_t, k_t, v_t, kk_t, a_t = inp
        S_kk = jnp.einsum('bhvk,bhk->bhv', S, kk_t)
        S = (S * w_t[:, :, None, :]
             - S_kk[..., :, None] * (kk_t * a_t)[:, :, None, :]
             + v_t[..., :, None] * k_t[..., None, :])
        y_t = jnp.einsum('bhvk,bhk->bhv', S, r_t)
        return S, y_t
    xs = tuple(jnp.moveaxis(t, 1, 0) for t in (r, w, k, v, kk, a))
    s_fin, ys = lax.scan(step, s0, xs, reverse=reverse)
    return jnp.moveaxis(ys, 0, 1), s_fin


def _mixer_layer(x, mod, s_fwd0, s_bwd0, norm_g, w_in, mu_shift, w0, w2, a0, a2,
                 k_k, k_a, r_k, gn_g, gn_b, w_fnet, b_fnet, w_out):
    B, T, _ = x.shape
    shift, scale, gate = jnp.split(mod, 3, axis=-1)
    h = _rmsnorm(x, norm_g) * (1 + scale[:, None]) + shift[:, None]
    proj = jnp.einsum('btd,de->bte', h, w_in)
    p_rec, g_rec, f_in, g_f = jnp.split(
        proj, [D_SHIFT, D_SHIFT + D_RWKV, D_SHIFT + D_RWKV + D_FNET], axis=-1)

    p_rec = (p_rec + mu_shift * (_centred_shift(p_rec) - p_rec)).astype(jnp.float32)
    r, k, v, lw, la = jnp.split(
        p_rec, [D_RWKV, 2 * D_RWKV, 3 * D_RWKV, 3 * D_RWKV + N_DIR * LORA_W], axis=-1)
    lw = lw.reshape(B, T, N_DIR, LORA_W)
    la = la.reshape(B, T, N_DIR, LORA_A)
    z_w = w0 + jnp.einsum('btdr,drc->btdc', jnp.tanh(lw), w2)
    decay = jnp.exp(-jnp.exp(-jax.nn.softplus(-z_w) - 0.5))
    a = jax.nn.sigmoid(a0 + jnp.einsum('btdr,drc->btdc', la, a2))
    k_dir = k[:, :, None] * (1 + (a - 1) * k_a)

    def heads(t):
        return t.reshape(t.shape[:-1] + (N_HEADS, HEAD_DIM))

    r_h, v_h = heads(r), heads(v)
    decay_h, a_h, k_h = heads(decay), heads(a), heads(k_dir)
    kk = heads(k * k_k)
    kk = kk / jnp.maximum(jnp.sqrt(jnp.sum(kk * kk, axis=-1, keepdims=True)), 1e-12)
    y_f, s_fwd = _rwkv7_scan(r_h, decay_h[:, :, 0], k_h[:, :, 0], v_h, kk, a_h[:, :, 0],
                             s_fwd0, False)
    y_b, s_bwd = _rwkv7_scan(r_h, decay_h[:, :, 1], k_h[:, :, 1], v_h, kk, a_h[:, :, 1],
                             s_bwd0, True)
    y = y_f + y_b
    mu = jnp.mean(y, axis=-1, keepdims=True)
    var = jnp.mean(jnp.square(y - mu), axis=-1, keepdims=True)
    y_n = (y - mu) * lax.rsqrt(var + GN_EPS) * gn_g + gn_b
    bonus = jnp.sum(r_h[:, :, None] * k_h * r_k, axis=(2, 4))[..., None] * v_h
    rec_out = (y_n + bonus).reshape(B, T, D_RWKV) * jax.nn.silu(g_rec.astype(jnp.float32))

    f = f_in.astype(jnp.float32).reshape(B, T, N_FGROUPS, FNET_GROUP)
    f_re = jnp.real(jnp.fft.fftn(f, axes=(1, 3), norm='ortho'))
    f_out = jnp.einsum('btgc,gce->btge', f_re, w_fnet.astype(jnp.float32)).reshape(B, T, D_FNET)
    f_out = (f_out + b_fnet) * jax.nn.silu(g_f.astype(jnp.float32))

    mixed = jnp.concatenate([rec_out, f_out], axis=-1).astype(x.dtype)
    out = jnp.einsum('btc,cd->btd', mixed, w_out)
    x = x + gate[:, None] * out
    return x, s_fwd, s_bwd


def setup_inputs(seed: int = 0) -> dict:
    key = jax.random.key(seed)
    ks = jax.random.split(key, 24)
    f32 = jnp.float32
    nrm = lambda k, s, sc: jax.random.normal(k, s, f32) * sc
    L = DEPTH
    return {
        "x_prompt": nrm(ks[0], (BATCH, SEQ, D_MODEL), 1.0),
        "x_sample": nrm(ks[1], (DEC_BATCH, DEC_SEQ, D_MODEL), 1.0),
        "state_rwkv_fwd": nrm(ks[2], (DEC_BATCH, L, N_HEADS, HEAD_DIM, HEAD_DIM), 0.3),
        "state_rwkv_bwd": nrm(ks[3], (DEC_BATCH, L, N_HEADS, HEAD_DIM, HEAD_DIM), 0.3),
        "c": nrm(ks[4], (DEC_BATCH, D_MODEL), 1.0),
        "c_ctx": nrm(ks[5], (D_MODEL,), 1.0),
        "w_ada": nrm(ks[6], (L, D_MODEL, 3 * D_MODEL), 0.5 * D_MODEL ** -0.5),
        "b_ada": nrm(ks[7], (L, 3 * D_MODEL), 0.01),
        "norm_g": 1.0 + nrm(ks[8], (L, D_MODEL), 0.01),
        "w_in": nrm(ks[9], (L, D_MODEL, D_IN), D_MODEL ** -0.5),
        "mu_shift": jax.random.uniform(ks[10], (L, D_SHIFT), f32),
        "w0": nrm(ks[11], (L, N_DIR, D_RWKV), 0.5),
        "w2": nrm(ks[12], (L, N_DIR, LORA_W, D_RWKV), 0.1),
        "a0": nrm(ks[13], (L, N_DIR, D_RWKV), 0.1),
        "a2": nrm(ks[14], (L, N_DIR, LORA_A, D_RWKV), 0.1),
        "k_k": 0.85 + nrm(ks[15], (L, D_RWKV), 0.02),
        "k_a": 1.0 + nrm(ks[16], (L, D_RWKV), 0.02),
        "r_k": nrm(ks[17], (L, N_HEADS, HEAD_DIM), 0.1),
        "gn_g": 1.0 + nrm(ks[18], (L, N_HEADS, HEAD_DIM), 0.01),
        "gn_b": nrm(ks[19], (L, N_HEADS, HEAD_DIM), 0.01),
        "w_fnet": nrm(ks[20], (L, N_FGROUPS, FNET_GROUP, FNET_GROUP), FNET_GROUP ** -0.5),
        "b_fnet": nrm(ks[21], (L, D_FNET), 0.01),
        "w_out": nrm(ks[22], (L, D_MODEL, D_MODEL), D_MODEL ** -0.5),
        "final_norm_g": 1.0 + nrm(ks[23], (D_MODEL,), 0.01),
    }


def reference(x_prompt, x_sample, state_rwkv_fwd, state_rwkv_bwd, c, c_ctx, w_ada, b_ada,
              norm_g, w_in, mu_shift, w0, w2, a0, a2, k_k, k_a, r_k, gn_g, gn_b,
              w_fnet, b_fnet, w_out, final_norm_g):
    xp = x_prompt
    bp = xp.shape[0]
    zero_state = jnp.zeros((bp, N_HEADS, HEAD_DIM, HEAD_DIM), jnp.float32)
    new_fwd, new_bwd = [], []
    for l in range(DEPTH):
        mod_ctx = (jax.nn.silu(c_ctx) @ w_ada[l] + b_ada[l])[None]
        xp, s_f, s_b = _mixer_layer(xp, mod_ctx, zero_state, zero_state, norm_g[l], w_in[l],
                                    mu_shift[l], w0[l], w2[l], a0[l], a2[l], k_k[l], k_a[l],
                                    r_k[l], gn_g[l], gn_b[l], w_fnet[l], b_fnet[l], w_out[l])
        new_fwd.append(s_f)
        new_bwd.append(s_b)
    y_prompt = _rmsnorm(xp, final_norm_g)
    new_state_rwkv_fwd = jnp.stack(new_fwd, axis=1)
    new_state_rwkv_bwd = jnp.stack(new_bwd, axis=1)

    xs = x_sample + _sincos_2d(x_sample.shape[1], x_sample.dtype)[None]
    for l in range(DEPTH):
        mod_lat = jax.nn.silu(c) @ w_ada[l] + b_ada[l]
        xs, _, _ = _mixer_layer(xs, mod_lat, state_rwkv_fwd[:, l].astype(jnp.float32),
                                state_rwkv_bwd[:, l].astype(jnp.float32), norm_g[l], w_in[l],
                                mu_shift[l], w0[l], w2[l], a0[l], a2[l], k_k[l], k_a[l],
                                r_k[l], gn_g[l], gn_b[l], w_fnet[l], b_fnet[l], w_out[l])
    y_sample = _rmsnorm(xs, final_norm_g)
    return (y_prompt, y_sample, new_state_rwkv_fwd, new_state_rwkv_bwd)
```

```cpp
#include <hip/hip_runtime.h>
#include <hip/hip_cooperative_groups.h>
#include <cstdio>
#include <cstdint>
namespace cg = cooperative_groups;

#define DEVINL __device__ __forceinline__
typedef unsigned short u16;
typedef __attribute__((ext_vector_type(8))) short bf16x8;
typedef __attribute__((ext_vector_type(4))) float f32x4;
typedef __attribute__((ext_vector_type(2))) float f32x2;
typedef __attribute__((ext_vector_type(2))) __bf16 bf16x2v;

constexpr int NTOK = 12288;
constexpr int NCTX = 8192;
constexpr int NPROJ = 2688;
constexpr int NIN = 3712;
#ifndef LATENT_MFMA
#define LATENT_MFMA 0
#endif
constexpr int THREADS = 256;
constexpr int LDS_BYTES = 65536 + 256;

constexpr size_t OFF_MOD    = 0;
constexpr size_t OFF_CNT    = 36864;
constexpr size_t OFF_BAR    = 36864 + 256;
constexpr size_t OFF_BAR2   = OFF_BAR + 13824;
constexpr size_t ZERO_BYTES = 65536;
static_assert(OFF_BAR2 + 13824 <= ZERO_BYTES, "barrier words");
constexpr size_t OFF_WTIN   = 65536;
constexpr size_t OFF_WOT    = OFF_WTIN + 7602176;
constexpr size_t OFF_W2T    = OFF_WOT + 2097152;
constexpr size_t OFF_ROWTAB = OFF_W2T + 131072;
constexpr size_t OFF_COLTAB = OFF_ROWTAB + 65536;
constexpr size_t OFF_A256   = OFF_COLTAB + 131072;
constexpr size_t OFF_BONUS  = OFF_A256 + 262144;
constexpr size_t OFF_M      = OFF_BONUS + 393216;
constexpr size_t OFF_H      = 11534336;
constexpr size_t OFF_PROJ   = OFF_H + 25165824;
constexpr size_t OFF_OPS_S  = OFF_PROJ + 66060288;
constexpr size_t OFF_OPS_D  = OFF_OPS_S + 37748736;
constexpr size_t OFF_GTL    = OFF_OPS_D + 75497472;
constexpr size_t OFF_A2048  = OFF_GTL + 8388608;
constexpr size_t OFF_GTC    = OFF_A2048 + 16777216;
constexpr size_t OFF_YBUF   = OFF_GTC;
constexpr size_t WS_NEED    = OFF_YBUF + 16777216;
static_assert(OFF_M + 262144 <= OFF_H, "small region overflow");
static_assert(OFF_GTC + 16777216 <= WS_NEED, "alias");
static_assert(WS_NEED <= 268435456, "workspace");

struct Params {
  const float *x_prompt, *x_sample, *st_f, *st_b, *c, *c_ctx, *w_ada, *b_ada, *norm_g, *w_in, *mu, *w0, *w2, *a0, *a2,
      *k_k, *k_a, *r_k, *gn_g, *gn_b, *w_fnet, *b_fnet, *w_out, *fng;
  float* out;
  char* ws;
  int use_cg;
  int pad_;
};

DEVINL uint32_t pack2bf(float a, float b) {
  f32x2 v = {a, b};
  bf16x2v r = __builtin_convertvector(v, bf16x2v);
  return __builtin_bit_cast(uint32_t, r);
}
DEVINL u16 f2bf(float a) { return (u16)(pack2bf(a, 0.f) & 0xFFFFu); }
DEVINL uint2 pack4bf(float a, float b, float c, float d) { return make_uint2(pack2bf(a, b), pack2bf(c, d)); }
DEVINL float bflo(uint32_t w) { return __uint_as_float(w << 16); }
DEVINL float bfhi(uint32_t w) { return __uint_as_float(w & 0xFFFF0000u); }
DEVINL uint32_t pack2h(float a, float b) {
  _Float16 ha = (_Float16)a, hb = (_Float16)b;
  return (uint32_t)__builtin_bit_cast(u16, ha) | ((uint32_t)__builtin_bit_cast(u16, hb) << 16);
}
DEVINL float hlo(uint32_t w) { return (float)__builtin_bit_cast(_Float16, (u16)(w & 0xFFFFu)); }
DEVINL float hhi(uint32_t w) { return (float)__builtin_bit_cast(_Float16, (u16)(w >> 16)); }
DEVINL int tid_opaque() { int t = threadIdx.x; asm volatile("" : "+v"(t)); return t; }
DEVINL size_t kb_off(int R, int row, int k) { return ((size_t)(k >> 6) * R + row) * 64 + (k & 63); }
DEVINL float rcp_f(float x) { return __builtin_amdgcn_rcpf(x); }
DEVINL float sigmoid_f(float x) { return rcp_f(1.f + __expf(-x)); }
DEVINL float silu_f(float x) { return x * sigmoid_f(x); }
DEVINL float amul(float a, float b) { float r; asm("v_mul_f32 %0, %1, %2" : "=v"(r) : "v"(a), "v"(b)); return r; }
DEVINL float afma(float a, float b, float c) { float r; asm("v_fma_f32 %0, %1, %2, %3" : "=v"(r) : "v"(a), "v"(b), "v"(c)); return r; }
DEVINL float afnma(float a, float b, float c) { float r; asm("v_fma_f32 %0, -%1, %2, %3" : "=v"(r) : "v"(a), "v"(b), "v"(c)); return r; }
template <int CTRL>
DEVINL float dpp_f(float x) {
  return __int_as_float(__builtin_amdgcn_update_dpp(0, __float_as_int(x), CTRL, 0xF, 0xF, false));
}
DEVINL float allreduce16(float x) {
  x += dpp_f<0x128>(x);
  x += dpp_f<0x124>(x);
  x += dpp_f<0x122>(x);
  x += dpp_f<0x121>(x);
  return x;
}
DEVINL float wave_sum(float x) {
#pragma unroll
  for (int o = 32; o >= 1; o >>= 1) x += __shfl_xor(x, o);
  return x;
}


#define XB_TMO      128
#define XB_XCNT(j)  (256  + 64 * (j))
#define XB_XSUB(j)  (1280 + 64 * (j))
#define XB_XGEN(j)  (2304 + 64 * (j))
#define XB_TOP      3328
#define XB_TOPGEN   3392
#define XCD_BAR_WORDS 3456
#define XB_SPIN_CAP (1u << 22)
#define LAS __attribute__((address_space(3)))
DEVINL unsigned xb_ld(unsigned* p) { return __hip_atomic_load(p, __ATOMIC_RELAXED, __HIP_MEMORY_SCOPE_AGENT); }
DEVINL unsigned xb_add(unsigned* p, unsigned v) { return __hip_atomic_fetch_add(p, v, __ATOMIC_RELAXED, __HIP_MEMORY_SCOPE_AGENT); }
DEVINL unsigned xb_xcc_id() { return (unsigned)__builtin_amdgcn_s_getreg((3 << 11) | 20) & 0xFu; }
#define XB_SPIN(cond, bar) do { unsigned _sp = 0; while (cond) { __builtin_amdgcn_s_sleep(1); \
    if ((++_sp & 255u) == 0u) { if (xb_ld(&(bar)[XB_TMO])) break; if (_sp > XB_SPIN_CAP) { atomicAdd(&(bar)[XB_TMO], 1u); break; } } } } while (0)
struct XcdBarrier { unsigned* bar; unsigned x; volatile LAS unsigned* st; unsigned total; };
DEVINL XcdBarrier xcd_barrier_post(unsigned* bar, volatile LAS unsigned* st, unsigned total) {
  XcdBarrier b; b.bar = bar; b.x = xb_xcc_id(); b.st = st; b.total = total;
  if (threadIdx.x == 0) (void)xb_add(&bar[XB_XCNT(b.x)], 1u);
  return b;
}
DEVINL void xcd_barrier_complete(unsigned* bar, unsigned x, unsigned G, unsigned& nloc, unsigned& nx) {
  unsigned sum, cnt, mine, sp = 0u;
  for (;;) {
    sum = 0u; cnt = 0u; mine = 0u;
#pragma unroll
    for (unsigned j = 0; j < 16; ++j) { const unsigned c = xb_ld(&bar[XB_XCNT(j)]); sum += c; cnt += (c > 0u) ? 1u : 0u; mine = (j == x) ? c : mine; }
    if (sum == G) break;
    __builtin_amdgcn_s_sleep(1);
    if ((++sp & 255u) == 0u) { if (xb_ld(&bar[XB_TMO])) break; if (sp > XB_SPIN_CAP) { atomicAdd(&bar[XB_TMO], 1u); break; } }
  }
  nloc = mine > 0u ? mine : 1u; nx = cnt > 0u ? cnt : 1u;
}
DEVINL void xcd_barrier(const XcdBarrier& b) {
  asm volatile("s_waitcnt vmcnt(0)" ::: "memory");
  __syncthreads();
  if (threadIdx.x == 0) {
    unsigned* bar = b.bar;
    __builtin_amdgcn_s_waitcnt(0);
    unsigned nloc = b.st[0], nx = b.st[1];
    if (nloc == 0u) { xcd_barrier_complete(bar, b.x, b.total, nloc, nx); b.st[0] = nloc; b.st[1] = nx; }
    const unsigned old = xb_add(&bar[XB_XSUB(b.x)], 1u);
    const unsigned gen = old / nloc;
    if (old + 1u == (gen + 1u) * nloc) {
      __builtin_amdgcn_fence(__ATOMIC_RELEASE, "agent");
      asm volatile("s_waitcnt vmcnt(0)" ::: "memory");
      const unsigned og = xb_add(&bar[XB_TOP], 1u);
      const unsigned tg = og / nx;
      if (og + 1u == (tg + 1u) * nx) xb_add(&bar[XB_TOPGEN], 1u);
      else XB_SPIN(xb_ld(&bar[XB_TOPGEN]) == tg, bar);
      __builtin_amdgcn_fence(__ATOMIC_ACQUIRE, "agent");
      xb_add(&bar[XB_XGEN(b.x)], 1u);
      asm volatile("s_waitcnt vmcnt(0)" ::: "memory");
    } else {
      XB_SPIN(xb_ld(&bar[XB_XGEN(b.x)]) == gen, bar);
      __builtin_amdgcn_fence(__ATOMIC_ACQUIRE, "agent");
      asm volatile("s_waitcnt vmcnt(0)" ::: "memory");
    }
  }
  __syncthreads();
}

DEVINL u16* ybuf_ptr(const Params& p, int d, size_t m) {
  return m < (size_t)NCTX ? (u16*)(p.ws + OFF_YBUF) + ((size_t)d * NCTX + m) * 512
                          : (u16*)(p.out + 8388608) + ((size_t)d * 4096 + (m - NCTX)) * 512;
}
DEVINL void unit_done(int* ctr) {
  asm volatile("s_waitcnt vmcnt(0)" ::: "memory");
  __syncthreads();
  if (threadIdx.x == 0) {
    __builtin_amdgcn_fence(__ATOMIC_RELEASE, "agent");
    asm volatile("s_waitcnt vmcnt(0)" ::: "memory");
    (void)xb_add((unsigned*)ctr, 1u);
  }
}
DEVINL void wait_for(int* ctr, int target) {
  if (threadIdx.x == 0) {
    unsigned sp = 0;
    while ((int)xb_ld((unsigned*)ctr) < target) { __builtin_amdgcn_s_sleep(2); if (++sp > (1u << 24)) break; }
    __builtin_amdgcn_fence(__ATOMIC_ACQUIRE, "agent");
    asm volatile("s_waitcnt vmcnt(0)" ::: "memory");
  }
  __syncthreads();
}

#define GT_WAIT(n) asm volatile("s_waitcnt vmcnt(" #n ")" ::: "memory")
DEVINL void gemm_core(const u16* __restrict__ P, size_t ksp, const u16* __restrict__ Q, size_t ksq, int nk, char* lds, f32x4 (&acc)[4][4]) {
  const int tid = tid_opaque(), lane = tid & 63, w = tid >> 6, wp = w >> 1, wq = w & 1;
  const int fr = lane & 15, fq = lane >> 4;
#pragma unroll
  for (int i = 0; i < 4; ++i)
#pragma unroll
    for (int j = 0; j < 4; ++j) acc[i][j] = (f32x4){0.f, 0.f, 0.f, 0.f};
  const char* Pb = (const char*)P;
  const char* Qb = (const char*)Q;
  unsigned so[2];
#pragma unroll
  for (int k = 0; k < 2; ++k) {
    const int R = (2 * w + k) * 16 + (lane >> 2);
    const int c = (lane & 3) ^ ((R & 8) ? 3 : 0);
    so[k] = (unsigned)(R * 128 + c * 16);
  }
  const int nst = nk * 2;
  auto issue = [&](int st) {
    const size_t kb = (size_t)(st >> 1);
    const unsigned kh = (unsigned)(st & 1) * 64u;
    char* dstp = lds + (st & 3) * 16384 + (2 * w) * 1024;
    const char* ps = Pb + kb * ksp + kh;
    const char* qs = Qb + kb * ksq + kh;
    __builtin_amdgcn_global_load_lds((const unsigned*)(ps + so[0]), (unsigned*)(dstp), 16, 0, 0);
    __builtin_amdgcn_global_load_lds((const unsigned*)(ps + so[1]), (unsigned*)(dstp + 1024), 16, 0, 0);
    __builtin_amdgcn_global_load_lds((const unsigned*)(qs + so[0]), (unsigned*)(dstp + 8192), 16, 0, 0);
    __builtin_amdgcn_global_load_lds((const unsigned*)(qs + so[1]), (unsigned*)(dstp + 8192 + 1024), 16, 0, 0);
  };
  issue(0);
  issue(1);
  issue(2);
  const int sw = (fr & 8) ? 3 : 0;
  const int roff = fr * 64 + ((fq ^ sw) << 4);
  for (int st = 0; st < nst; ++st) {
    if (st + 2 < nst) GT_WAIT(8); else if (st + 1 < nst) GT_WAIT(4); else GT_WAIT(0);
    __builtin_amdgcn_s_barrier();
    if (st + 3 < nst) issue(st + 3);
    const char* bp = lds + (st & 3) * 16384;
    const char* bq = bp + 8192;
    bf16x8 a[4], b[4];
#pragma unroll
    for (int i = 0; i < 4; ++i) {
      a[i] = *(const bf16x8*)(bp + (64 * wp + 16 * i) * 64 + roff);
      b[i] = *(const bf16x8*)(bq + (64 * wq + 16 * i) * 64 + roff);
    }
#pragma unroll
    for (int i = 0; i < 4; ++i)
#pragma unroll
      for (int j = 0; j < 4; ++j) acc[i][j] = __builtin_amdgcn_mfma_f32_16x16x32_bf16(a[i], b[j], acc[i][j], 0, 0, 0);
  }
  __syncthreads();
}
template <class Epi>
DEVINL void gemm_tile(const u16* __restrict__ P, size_t ksp, const u16* __restrict__ Q, size_t ksq, int nk, char* lds, Epi epi) {
  f32x4 acc[4][4];
  gemm_core(P, ksp, Q, ksq, nk, lds, acc);
  const int tid = tid_opaque(), lane = tid & 63, w = tid >> 6, wp = w >> 1, wq = w & 1;
  const int fr = lane & 15, fq = lane >> 4;
#pragma unroll
  for (int i = 0; i < 4; ++i)
#pragma unroll
    for (int j = 0; j < 4; ++j) epi(64 * wp + 16 * i + 4 * fq, 64 * wq + 16 * j + fr, acc[i][j]);
}

DEVINL void transpose_unit(const float* __restrict__ src, int ld, int k0, int c0, u16* __restrict__ dst, int R, int n0, float* tile) {
  const int tid = tid_opaque();
#pragma unroll 4
  for (int i = 0; i < 16; ++i) {
    int kk = (tid >> 6) + 4 * i, nn = tid & 63;
    tile[kk * 65 + nn] = src[(size_t)(k0 + kk) * ld + c0 + nn];
  }
  __syncthreads();
#pragma unroll
  for (int i = 0; i < 2; ++i) {
    int nn = (tid >> 3) + 32 * i, kc = tid & 7;
    const float* t = tile + (kc * 8) * 65 + nn;
    uint4 o;
    o.x = pack2bf(t[0], t[65]);
    o.y = pack2bf(t[130], t[195]);
    o.z = pack2bf(t[260], t[325]);
    o.w = pack2bf(t[390], t[455]);
    *(uint4*)(dst + kb_off(R, n0 + nn, k0 + kc * 8)) = o;
  }
  __syncthreads();
}

__device__ void phase0(const Params& p, char* lds) {
  const int tid = tid_opaque();
  float* ldsf = (float*)lds;
  float* mod = (float*)(p.ws + OFF_MOD);
  constexpr int NU_M = 64, NU_MOD = 384, NU_TIN = 672, NU_TOUT = 256;
  constexpr int NU = NU_M + NU_MOD + NU_TIN + NU_TOUT;
  for (int u = blockIdx.x; u < NU; u += gridDim.x) {
    if (u < NU_M) {
      const int g = u >> 3, c8 = u & 7;
      float* tabc = ldsf; float* tabs = ldsf + 64;
      if (tid < 64) { float s, c; sincospif((float)tid * (1.f / 32.f), &s, &c); tabc[tid] = c; tabs[tid] = s; }
      __syncthreads();
      const int j2 = tid & 127, jj = j2 & 63;
      const float* tab = (j2 >> 6) ? tabs : tabc;
      const float* wf = p.w_fnet + (size_t)g * 4096 + jj;
      float* Mo = (float*)(p.ws + OFF_M) + (size_t)g * 8192;
      {
        const int cb = c8 * 8 + (tid >> 7);
        float s0 = 0.f, s1 = 0.f, s2 = 0.f, s3 = 0.f;
#pragma unroll 16
        for (int e = 0; e < 64; ++e) {
          const float wv = wf[e * 64];
          s0 += tab[(cb * e) & 63] * wv;
          s1 += tab[((cb + 2) * e) & 63] * wv;
          s2 += tab[((cb + 4) * e) & 63] * wv;
          s3 += tab[((cb + 6) * e) & 63] * wv;
        }
        Mo[cb * 128 + j2] = s0; Mo[(cb + 2) * 128 + j2] = s1; Mo[(cb + 4) * 128 + j2] = s2; Mo[(cb + 6) * 128 + j2] = s3;
      }
      __syncthreads();
    } else if (u < NU_M + NU_MOD) {
      const int v = u - NU_M;
      const int cb = v % 12, ks = v / 12;
      const int col = cb * 256 + tid;
      float a0 = 0.f, a1 = 0.f, a2 = 0.f;
      if (tid < 96) {
        const int kk = ks * 32 + (tid & 31), which = tid >> 5;
        const float cv = which == 0 ? p.c_ctx[kk] : p.c[(which - 1) * 1024 + kk];
        ldsf[tid] = silu_f(cv);
      }
      __syncthreads();
#pragma unroll 8
      for (int k = 0; k < 32; ++k) {
        float wv = p.w_ada[(size_t)(ks * 32 + k) * 3072 + col];
        a0 += ldsf[k] * wv;
        a1 += ldsf[32 + k] * wv;
        a2 += ldsf[64 + k] * wv;
      }
      __syncthreads();
      if (ks == 0) { float bb = p.b_ada[col]; a0 += bb; a1 += bb; a2 += bb; }
      unsafeAtomicAdd(&mod[col], a0);
      unsafeAtomicAdd(&mod[3072 + col], a1);
      unsafeAtomicAdd(&mod[6144 + col], a2);
    } else if (u < NU_M + NU_MOD + NU_TIN) {
      const int v = u - NU_M - NU_MOD;
      const int ktile = v & 15, ntile = v >> 4;
      const int n0 = ntile * 64;
      const int c0 = n0 < 2176 ? n0 : n0 + 512;
      transpose_unit(p.w_in, 3200, ktile * 64, c0, (u16*)(p.ws + OFF_WTIN), NIN, n0, ldsf);
    } else {
      const int v = u - NU_M - NU_MOD - NU_TIN;
      const int ktile = v & 15, ntile = v >> 4;
      transpose_unit(p.w_out, 1024, ktile * 64, ntile * 64, (u16*)(p.ws + OFF_WOT), 1024, ntile * 64, ldsf);
    }
  }
  const int gt = blockIdx.x * THREADS + tid, gn = gridDim.x * THREADS;
  {
    u16* w2t = (u16*)(p.ws + OFF_W2T);
    for (int i = gt; i < 65536; i += gn) {
      int j = i & 31, c = (i >> 5) & 511, combo = i >> 14;
      int d = combo >> 1;
      const float* src = (combo & 1) ? p.a2 : p.w2;
      w2t[i] = f2bf(src[((size_t)d * 32 + j) * 512 + c]);
    }
  }
  {
    float* rowtab = (float*)(p.ws + OFF_ROWTAB);
    float* coltab = (float*)(p.ws + OFF_COLTAB);
    for (int i = gt; i < 96 * 256; i += gn) {
      int f = i & 255, pos = i >> 8;
      float freq = expf(-9.210340371976184f * (float)f * (1.f / 256.f));
      float pv = pos < 32 ? (float)pos : (float)(pos - 32);
      float ang = pv * freq;
      float s = sinf(ang), c = cosf(ang);
      float* dst = pos < 32 ? rowtab + pos * 512 : coltab + (pos - 32) * 512;
      dst[f] = s; dst[256 + f] = c;
    }
  }
  {
    u16* a256 = (u16*)(p.ws + OFF_A256);
    for (int i = gt; i < 256 * 256; i += gn) {
      int k = i & 255, tp = i >> 8;
      int m = (tp * k) & 255;
      float s, c; sincospif((float)m * (1.f / 128.f), &s, &c);
      a256[kb_off(256, tp, k)] = f2bf(c);
      a256[kb_off(256, tp, 256 + k)] = f2bf(-s);
    }
    u16* a2048 = (u16*)(p.ws + OFF_A2048);
    __syncthreads();
    float* ctab = ldsf;
    for (int m = tid; m < 2048; m += THREADS) { float sn, cs; sincospif((float)m * (1.f / 1024.f), &sn, &cs); ctab[m] = cs; }
    __syncthreads();
    for (int i = gt; i < 2048 * 2048; i += gn) {
      int k = i & 2047, tp = i >> 11;
      int m = (tp * k) & 2047;
      a2048[kb_off(2048, tp, k)] = f2bf(ctab[m]);
      a2048[kb_off(2048, tp, 2048 + k)] = f2bf(-ctab[(m - 512) & 2047]);
    }
  }
}

__device__ void phase1(const Params& p, char* lds) {
  const int tid = tid_opaque(), lane = tid & 63, w = tid >> 6;
  float* ldsf = (float*)lds;
  const float* mod = (const float*)(p.ws + OFF_MOD);
  const float* rowtab = (const float*)(p.ws + OFF_ROWTAB);
  const float* coltab = (const float*)(p.ws + OFF_COLTAB);
  u16* hbuf = (u16*)(p.ws + OFF_H);
  constexpr int NU_FOLD = 512, NU_ROWS = NTOK / 4;
  for (int u = blockIdx.x; u < NU_FOLD + NU_ROWS; u += gridDim.x) {
    if (u < NU_FOLD) {
      const int g = u >> 6, k0 = ((u >> 2) & 15) * 64, jq = (u & 3) * 32;
      float* Ml = ldsf;
      float* Wl = ldsf + 2048;
      const float* Mg = (const float*)(p.ws + OFF_M) + (size_t)g * 8192 + jq;
      for (int i = tid; i < 512; i += THREADS) ((float4*)Ml)[i] = *(const float4*)(Mg + (i >> 3) * 128 + (i & 7) * 4);
#pragma unroll 4
      for (int i = 0; i < 16; ++i) {
        int kk = (tid >> 6) + 4 * i, cc = tid & 63;
        Wl[kk * 65 + cc] = p.w_in[(size_t)(k0 + kk) * 3200 + 2176 + g * 64 + cc];
      }
      __syncthreads();
      u16* dst = (u16*)(p.ws + OFF_WTIN);
      for (int grp = 0; grp < 2; ++grp) {
        const int jl = w * 8 + grp * 4;
        float s0 = 0.f, s1 = 0.f, s2 = 0.f, s3 = 0.f;
#pragma unroll 8
        for (int cc = 0; cc < 64; ++cc) {
          float wl = Wl[lane * 65 + cc];
          float4 m4 = *(const float4*)(Ml + cc * 32 + jl);
          s0 += wl * m4.x; s1 += wl * m4.y; s2 += wl * m4.z; s3 += wl * m4.w;
        }
        size_t o = kb_off(NIN, 2688 + g * 128 + jq + jl, k0 + lane);
        dst[o] = f2bf(s0); dst[o + 64] = f2bf(s1); dst[o + 128] = f2bf(s2); dst[o + 192] = f2bf(s3);
      }
      __syncthreads();
    } else {
      const int m = (u - NU_FOLD) * 4 + w;
      const bool lat = m >= NCTX;
      const int mp = m - NCTX;
      const int t = mp & 2047;
      const int mi = lat ? 1 + (mp >> 11) : 0;
      const float* xr = lat ? p.x_sample + (size_t)mp * 1024 : p.x_prompt + (size_t)m * 1024;
      float4 v[4];
      float ss = 0.f;
#pragma unroll
      for (int i = 0; i < 4; ++i) {
        const int col = lane * 4 + 256 * i;
        v[i] = *(const float4*)(xr + col);
        if (lat) {
          const float* e = col < 512 ? rowtab + (t >> 6) * 512 + col : coltab + (t & 63) * 512 + (col - 512);
          float4 e4 = *(const float4*)e;
          v[i].x += e4.x; v[i].y += e4.y; v[i].z += e4.z; v[i].w += e4.w;
        }
        ss += v[i].x * v[i].x + v[i].y * v[i].y + v[i].z * v[i].z + v[i].w * v[i].w;
      }
      ss = wave_sum(ss);
      const float rstd = rsqrtf(ss * (1.f / 1024.f) + 1e-6f);
#pragma unroll
      for (int i = 0; i < 4; ++i) {
        const int col = lane * 4 + 256 * i;
        float4 g4 = *(const float4*)(p.norm_g + col);
        float4 sh = *(const float4*)(mod + mi * 3072 + col);
        float4 sc = *(const float4*)(mod + mi * 3072 + 1024 + col);
        float h0 = v[i].x * rstd * g4.x * (1.f + sc.x) + sh.x;
        float h1 = v[i].y * rstd * g4.y * (1.f + sc.y) + sh.y;
        float h2 = v[i].z * rstd * g4.z * (1.f + sc.z) + sh.z;
        float h3 = v[i].w * rstd * g4.w * (1.f + sc.w) + sh.w;
        *(uint2*)(hbuf + kb_off(NTOK, m, col)) = pack4bf(h0, h1, h2, h3);
      }
    }
  }
}

DEVINL void inproj_tile(const Params& p, int id, char* lds) {
  const u16* hbuf = (const u16*)(p.ws + OFF_H);
  const u16* wt = (const u16*)(p.ws + OFF_WTIN);
  u16* proj = (u16*)(p.ws + OFF_PROJ);
  u16* gtc = (u16*)(p.ws + OFF_GTC);
  u16* gtl = (u16*)(p.ws + OFF_GTL);
  constexpr int NT = 29;
  constexpr size_t KS_W = (size_t)NIN * 128, KS_H = (size_t)NTOK * 128;
  const int mg = id / (NT * 8), rem = id % (NT * 8);
  const int nt = rem >> 3, mt = mg * 8 + (rem & 7);
  const int m0 = mt * 128, n0 = nt * 128;
  if (nt < 21) {
    f32x4 acc[4][4];
    gemm_core(wt + (size_t)n0 * 64, KS_W, hbuf + (size_t)m0 * 64, KS_H, 16, lds, acc);
    const int tid = tid_opaque(), lane = tid & 63, w = tid >> 6, wp = w >> 1, wq = w & 1, fr = lane & 15, fq = lane >> 4;
    constexpr int CST = 272;
#pragma unroll
    for (int i = 0; i < 4; ++i)
#pragma unroll
      for (int j = 0; j < 4; ++j) {
        const int ql = 64 * wq + 16 * j + fr, pl = 64 * wp + 16 * i + 4 * fq;
        *(uint2*)(lds + ql * CST + pl * 2) = pack4bf(acc[i][j][0], acc[i][j][1], acc[i][j][2], acc[i][j][3]);
      }
    __syncthreads();
#pragma unroll
    for (int k = 0; k < 8; ++k) {
      const int row = (tid >> 4) + 16 * k, c16 = tid & 15;
      const uint4 v = *(const uint4*)(lds + row * CST + c16 * 16);
      *(uint4*)(proj + (size_t)(m0 + row) * NPROJ + n0 + c16 * 8) = v;
    }
    __syncthreads();
  } else {
    const int g = nt - 21;
    f32x4 acc[4][4];
    gemm_core(hbuf + (size_t)m0 * 64, KS_H, wt + (size_t)n0 * 64, KS_W, 16, lds, acc);
    const int tid = tid_opaque(), lane = tid & 63, w = tid >> 6, wp = w >> 1, wq = w & 1, fr = lane & 15, fq = lane >> 4;
    constexpr int CST = 272;
#pragma unroll
    for (int i = 0; i < 4; ++i)
#pragma unroll
      for (int j = 0; j < 4; ++j) {
        const int ql = 64 * wq + 16 * j + fr, pl = 64 * wp + 16 * i + 4 * fq;
        *(uint2*)(lds + ql * CST + pl * 2) = pack4bf(acc[i][j][0], acc[i][j][1], acc[i][j][2], acc[i][j][3]);
      }
    __syncthreads();
    const bool isctx = m0 < NCTX;
    const int bb = isctx ? (m0 >> 8) : ((m0 - NCTX) >> 11);
    const int tb = isctx ? (m0 & 255) : ((m0 - NCTX) & 2047);
#pragma unroll
    for (int k = 0; k < 8; ++k) {
      const int row = (tid >> 4) + 16 * k, c16 = tid & 15;
      const uint4 v = *(const uint4*)(lds + row * CST + c16 * 16);
      const int part = row >> 6, cp = row & 63, t = tb + c16 * 8;
      u16* dst = isctx ? gtc + kb_off(16384, (bb * 8 + g) * 64 + cp, part * 256 + t)
                       : gtl + kb_off(1024, (bb * 8 + g) * 64 + cp, part * 2048 + t);
      *(uint4*)dst = v;
    }
    __syncthreads();
  }
}
__device__ void phase2_all(const Params& p, char* lds) {
  constexpr int NTILES = 29 * 96;
  int first, step, last;
  if ((gridDim.x & 7) == 0) { const int per = NTILES / 8, x = blockIdx.x & 7; first = x * per + (blockIdx.x >> 3); step = gridDim.x >> 3; last = (x + 1) * per; }
  else { first = blockIdx.x; step = gridDim.x; last = NTILES; }
  for (int id = first; id < last; id += step) inproj_tile(p, id, lds);
}

DEVINL void mix4(const u16* prow, bool hasPrev, bool hasNext, const float* mu, int col, float* o) {
  uint2 c = *(const uint2*)(prow + col);
  uint2 pv = make_uint2(0u, 0u), nx = make_uint2(0u, 0u);
  if (hasPrev) pv = *(const uint2*)(prow - NPROJ + col);
  if (hasNext) nx = *(const uint2*)(prow + NPROJ + col);
  float4 m4 = *(const float4*)(mu + col);
  float c0 = bflo(c.x), c1 = bfhi(c.x), c2 = bflo(c.y), c3 = bfhi(c.y);
  o[0] = c0 + m4.x * (0.5f * (bflo(pv.x) + bflo(nx.x)) - c0);
  o[1] = c1 + m4.y * (0.5f * (bfhi(pv.x) + bfhi(nx.x)) - c1);
  o[2] = c2 + m4.z * (0.5f * (bflo(pv.y) + bflo(nx.y)) - c2);
  o[3] = c3 + m4.w * (0.5f * (bfhi(pv.y) + bfhi(nx.y)) - c3);
}
DEVINL void mix8(const u16* prow, bool hasPrev, bool hasNext, const float* mu, int col, float* o) {
  mix4(prow, hasPrev, hasNext, mu, col, o);
  mix4(prow, hasPrev, hasNext, mu, col + 4, o + 4);
}
DEVINL float tanh_f(float x) {
  float e = __expf(2.f * x);
  return 1.f - 2.f * rcp_f(e + 1.f);
}

DEVINL void prep_item(const Params& p, int item, int lane) {
  const int tile = item >> 3, h = item & 7;
  const int r = lane & 15, q = lane >> 4;
  const int m = tile * 16 + r;
  int T, t;
  if (m < NCTX) { T = 256; t = m & 255; } else { T = 2048; t = (m - NCTX) & 2047; }
  const bool hasPrev = t > 0, hasNext = t < T - 1;
  const u16* prow = (const u16*)(p.ws + OFF_PROJ) + (size_t)m * NPROJ;
  const u16* w2t = (const u16*)(p.ws + OFF_W2T);
  u16* ops_s = (u16*)(p.ws + OFF_OPS_S) + ((size_t)m * 8 + h) * 192;
  u16* ops_d = (u16*)(p.ws + OFF_OPS_D) + ((size_t)m * 8 + h) * 384;

  bf16x8 xw[2], xa[2];
#pragma unroll
  for (int d = 0; d < 2; ++d) {
    float t8[8];
    mix8(prow, hasPrev, hasNext, p.mu, 1536 + d * 32 + 8 * q, t8);
#pragma unroll
    for (int e = 0; e < 8; ++e) t8[e] = tanh_f(t8[e]);
    uint4 pk = make_uint4(pack2bf(t8[0], t8[1]), pack2bf(t8[2], t8[3]), pack2bf(t8[4], t8[5]), pack2bf(t8[6], t8[7]));
    xw[d] = __builtin_bit_cast(bf16x8, pk);
    mix8(prow, hasPrev, hasNext, p.mu, 1600 + d * 32 + 8 * q, t8);
    pk = make_uint4(pack2bf(t8[0], t8[1]), pack2bf(t8[2], t8[3]), pack2bf(t8[4], t8[5]), pack2bf(t8[6], t8[7]));
    xa[d] = __builtin_bit_cast(bf16x8, pk);
  }
  float nsq = 0.f;
#pragma unroll 1
  for (int mt = 0; mt < 4; ++mt) {
    const int ch = h * 64 + 16 * mt + 4 * q;
    float kp[4];
    mix4(prow, hasPrev, hasNext, p.mu, 512 + ch, kp);
    float4 kk4 = *(const float4*)(p.k_k + ch);
    float a0 = kp[0] * kk4.x, a1 = kp[1] * kk4.y, a2 = kp[2] * kk4.z, a3 = kp[3] * kk4.w;
    nsq += a0 * a0 + a1 * a1 + a2 * a2 + a3 * a3;
  }
  nsq += __shfl_xor(nsq, 16);
  nsq += __shfl_xor(nsq, 32);
  const float inv = 1.f / fmaxf(sqrtf(nsq), 1e-12f);
  float bon = 0.f;
#pragma unroll 1
  for (int mt = 0; mt < 4; ++mt) {
    const int c = 16 * mt + 4 * q;
    const int ch = h * 64 + c;
    float rp[4], vp[4], kk[4], kp[4];
    mix4(prow, hasPrev, hasNext, p.mu, 512 + ch, kp);
    mix4(prow, hasPrev, hasNext, p.mu, ch, rp);
    mix4(prow, hasPrev, hasNext, p.mu, 1024 + ch, vp);
    {
      float4 kk4 = *(const float4*)(p.k_k + ch);
      kk[0] = kp[0] * kk4.x * inv; kk[1] = kp[1] * kk4.y * inv; kk[2] = kp[2] * kk4.z * inv; kk[3] = kp[3] * kk4.w * inv;
    }
    *(uint2*)(ops_s + c) = pack4bf(kk[0], kk[1], kk[2], kk[3]);
    *(uint2*)(ops_s + 64 + c) = pack4bf(rp[0], rp[1], rp[2], rp[3]);
    *(uint2*)(ops_s + 128 + c) = pack4bf(vp[0], vp[1], vp[2], vp[3]);
    const float4 ka4 = *(const float4*)(p.k_a + ch);
    const float4 rk4 = *(const float4*)(p.r_k + ch);
    const float kav[4] = {ka4.x, ka4.y, ka4.z, ka4.w};
    const float rkv[4] = {rk4.x, rk4.y, rk4.z, rk4.w};
#pragma unroll
    for (int d = 0; d < 2; ++d) {
      bf16x8 aw = *(const bf16x8*)(w2t + ((size_t)((d * 2 + 0) * 512 + h * 64 + 16 * mt + r)) * 32 + 8 * q);
      bf16x8 aa = *(const bf16x8*)(w2t + ((size_t)((d * 2 + 1) * 512 + h * 64 + 16 * mt + r)) * 32 + 8 * q);
      f32x4 z0 = {0.f, 0.f, 0.f, 0.f};
      f32x4 zw = __builtin_amdgcn_mfma_f32_16x16x32_bf16(aw, xw[d], z0, 0, 0, 0);
      f32x4 za = __builtin_amdgcn_mfma_f32_16x16x32_bf16(aa, xa[d], z0, 0, 0, 0);
      const float4 w04 = *(const float4*)(p.w0 + d * 512 + ch);
      const float4 a04 = *(const float4*)(p.a0 + d * 512 + ch);
      const float w0v[4] = {w04.x, w04.y, w04.z, w04.w};
      const float a0v[4] = {a04.x, a04.y, a04.z, a04.w};
      float wd[4], kd[4], bb[4];
#pragma unroll
      for (int i = 0; i < 4; ++i) {
        float sg = sigmoid_f(zw[i] + w0v[i]);
        wd[i] = __expf(-0.6065306597126334f * sg);
        float av = sigmoid_f(za[i] + a0v[i]);
        kd[i] = kp[i] * (1.f + (av - 1.f) * kav[i]);
        bb[i] = kk[i] * av;
        bon += rp[i] * kd[i] * rkv[i];
      }
      u16* pd = ops_d + d * 192;
      *(uint2*)(pd + c) = make_uint2(pack2h(wd[0], wd[1]), pack2h(wd[2], wd[3]));
      *(uint2*)(pd + 64 + c) = pack4bf(kd[0], kd[1], kd[2], kd[3]);
      *(uint2*)(pd + 128 + c) = pack4bf(bb[0], bb[1], bb[2], bb[3]);
    }
  }
  bon += __shfl_xor(bon, 16);
  bon += __shfl_xor(bon, 32);
  if (q == 0) ((float*)(p.ws + OFF_BONUS))[(size_t)m * 8 + h] = bon;
}

DEVINL void fnet_tile(const Params& p, bool latn, int u, char* lds) {
  const int tid = tid_opaque(), lane = tid & 63, w = tid >> 6;
  const u16* proj = (const u16*)(p.ws + OFF_PROJ);
  u16* mixed = (u16*)(p.ws + OFF_H);
  {
      int p0, q0; size_t mbase; float scale;
      f32x4 acc[4][4];
      if (latn) {
        p0 = (u & 7) * 128; q0 = (u >> 3) * 128;
        scale = 0.002762135864009951f;
        mbase = NCTX + (size_t)(p0 >> 9) * 2048 + q0;
        gemm_core((const u16*)(p.ws + OFF_GTL) + (size_t)p0 * 64, (size_t)1024 * 128, (const u16*)(p.ws + OFF_A2048) + (size_t)q0 * 64, (size_t)2048 * 128, 64, lds, acc);
      } else {
        const int v0 = u;
        p0 = (v0 >> 1) * 128; q0 = (v0 & 1) * 128;
        scale = 0.0078125f;
        mbase = (size_t)(p0 >> 9) * 256 + q0;
        gemm_core((const u16*)(p.ws + OFF_GTC) + (size_t)p0 * 64, (size_t)16384 * 128, (const u16*)(p.ws + OFF_A256) + (size_t)q0 * 64, (size_t)256 * 128, 8, lds, acc);
      }
      const int wp = w >> 1, wq = w & 1, fr = lane & 15, fq = lane >> 4;
      const int gc0 = (p0 & 511) + 64 * wp + 4 * fq;
      const size_t m0 = mbase + 64 * wq + fr;
      uint2 gf[4][4];
      float4 b4[4];
#pragma unroll
      for (int i = 0; i < 4; ++i) {
        b4[i] = *(const float4*)(p.b_fnet + gc0 + 16 * i);
#pragma unroll
        for (int j = 0; j < 4; ++j) gf[i][j] = *(const uint2*)(proj + (m0 + 16 * j) * NPROJ + 2176 + gc0 + 16 * i);
      }
#pragma unroll
      for (int i = 0; i < 4; ++i)
#pragma unroll
        for (int j = 0; j < 4; ++j) {
          const f32x4 v = acc[i][j];
          float o0 = (v[0] * scale + b4[i].x) * silu_f(bflo(gf[i][j].x));
          float o1 = (v[1] * scale + b4[i].y) * silu_f(bfhi(gf[i][j].x));
          float o2 = (v[2] * scale + b4[i].z) * silu_f(bflo(gf[i][j].y));
          float o3 = (v[3] * scale + b4[i].w) * silu_f(bfhi(gf[i][j].y));
          *(uint2*)(mixed + kb_off(NTOK, (int)(m0 + 16 * j), 512 + gc0 + 16 * i)) = pack4bf(o0, o1, o2, o3);
        }
  }
}

DEVINL int next_unit(int* counter, char* lds) {
  volatile int* slot = (volatile int*)(lds + 65536);
  __syncthreads();
  if (threadIdx.x == 0) *slot = atomicAdd(counter, 1);
  __syncthreads();
  return *slot;
}

__device__ void phase3_latent(const Params& p) {
  const int tid = tid_opaque(), lane = tid & 63, w = tid >> 6;
  for (int it = blockIdx.x * 4 + w; it < 2048; it += gridDim.x * 4) prep_item(p, 4096 + it, lane);
}

struct StepOps { f32x4 kk, r, w, kd, b; float v; };
DEVINL StepOps load_ops(const float* L, int j, int row) {
  StepOps o;
  o.kk = *(const f32x4*)(L + 4 * j);
  o.r = *(const f32x4*)(L + 64 + 4 * j);
  o.v = L[128 + row];
  o.w = *(const f32x4*)(L + 192 + 4 * j);
  o.kd = *(const f32x4*)(L + 256 + 4 * j);
  o.b = *(const f32x4*)(L + 320 + 4 * j);
  return o;
}
template <int DIR>
DEVINL void scan_unit(const Params& p, int T, int tokbase, int b, int h, int qq, bool ctx, char* lds) {
  constexpr int d = DIR;
  const int tid = tid_opaque(), lane = tid & 63, w = tid >> 6;
  const int g = lane >> 4, j = lane & 15;
  const int row = qq * 16 + w * 4 + g;
  float S0 = 0.f, S1 = 0.f, S2 = 0.f, S3 = 0.f;
  if (!ctx) {
    const float* s0 = (d ? p.st_b : p.st_f) + ((size_t)(b * 8 + h) * 64 + row) * 64 + 4 * j;
    f32x4 s4 = *(const f32x4*)s0;
    S0 = s4[0]; S1 = s4[1]; S2 = s4[2]; S3 = s4[3];
  }
  const u16* ops_s = (const u16*)(p.ws + OFF_OPS_S);
  const u16* ops_d = (const u16*)(p.ws + OFF_OPS_D);
  float* ldsf = (float*)lds;
  u16* yout = ybuf_ptr(p, d, (size_t)tokbase) + h * 64 + row;
  const int nchunks = T >> 4;
  int ps[3], pw[3];
#pragma unroll
  for (int i = 0; i < 3; ++i) { int pi = tid + 256 * i; ps[i] = pi / 48; pw[i] = pi % 48; }
  uint4 rg0[3], rg1[3], rg2[3], rg3[3];
  const char* gp[3];
  int gst[3];
#pragma unroll
  for (int i = 0; i < 3; ++i) {
    const size_t tok = (size_t)(tokbase + (d ? T - 16 : 0) + ps[i]);
    const u16* src = pw[i] < 24 ? ops_s + (tok * 8 + h) * 192 + pw[i] * 8
                                : ops_d + ((tok * 8 + h) * 2 + d) * 192 + (pw[i] - 24) * 8;
    gp[i] = (const char*)src;
    gst[i] = (pw[i] < 24 ? 16 * 8 * 192 * 2 : 16 * 8 * 2 * 192 * 2) * (d ? -1 : 1);
  }
  auto gload = [&](int c, uint4 (&r)[3]) __attribute__((always_inline)) {
    (void)c;
#pragma unroll
    for (int i = 0; i < 3; ++i) { r[i] = *(const uint4*)gp[i]; gp[i] += gst[i]; }
  };
  auto lstore = [&](int buf, const uint4 (&r)[3]) __attribute__((always_inline)) {
#pragma unroll
    for (int i = 0; i < 3; ++i) {
      float* dst = ldsf + buf * 6144 + ps[i] * 384 + pw[i] * 8;
      float4 a, bq;
      if (pw[i] >= 24 && pw[i] < 32) {
        a = make_float4(hlo(r[i].x), hhi(r[i].x), hlo(r[i].y), hhi(r[i].y));
        bq = make_float4(hlo(r[i].z), hhi(r[i].z), hlo(r[i].w), hhi(r[i].w));
      } else {
        a = make_float4(bflo(r[i].x), bfhi(r[i].x), bflo(r[i].y), bfhi(r[i].y));
        bq = make_float4(bflo(r[i].z), bfhi(r[i].z), bflo(r[i].w), bfhi(r[i].w));
      }
      *(float4*)dst = a;
      *(float4*)(dst + 4) = bq;
    }
  };
  gload(0, rg0);
  gload(1, rg1);
  gload(2, rg2);
  lstore(0, rg0);
  __syncthreads();
  auto chunk = [&](const int c, const int cc, uint4 (&ldset)[3], const uint4 (&stset)[3]) __attribute__((always_inline)) {
    {
      if (c + 3 < nchunks) gload(c + 3, ldset);
      const float* L0 = ldsf + (cc & 1) * 6144;
      const int t0 = d ? T - 16 * (c + 1) : 16 * c;
      StepOps ring[3];
      ring[0] = load_ops(L0 + (d ? 15 : 0) * 384, j, row);
      ring[1] = load_ops(L0 + (d ? 14 : 1) * 384, j, row);
      float ykeep = 0.f;
#pragma unroll
      for (int s = 0; s < 16; ++s) {
        const int li = d ? 15 - s : s;
        if (s + 2 < 16) ring[(s + 2) % 3] = load_ops(L0 + (d ? 13 - s : s + 2) * 384, j, row);
        __builtin_amdgcn_sched_barrier(0);
        const StepOps& cur = ring[s % 3];
        float ua = amul(S0, cur.kk[0]);
        float ub = amul(S2, cur.kk[2]);
        ua = afma(S1, cur.kk[1], ua);
        ub = afma(S3, cur.kk[3], ub);
        const float u = allreduce16(ua + ub);
        float t0 = amul(cur.v, cur.kd[0]), t1 = amul(cur.v, cur.kd[1]), t2 = amul(cur.v, cur.kd[2]), t3 = amul(cur.v, cur.kd[3]);
        t0 = afnma(u, cur.b[0], t0); t1 = afnma(u, cur.b[1], t1); t2 = afnma(u, cur.b[2], t2); t3 = afnma(u, cur.b[3], t3);
        S0 = afma(S0, cur.w[0], t0); S1 = afma(S1, cur.w[1], t1); S2 = afma(S2, cur.w[2], t2); S3 = afma(S3, cur.w[3], t3);
        float ya = amul(S0, cur.r[0]);
        float yb = amul(S2, cur.r[2]);
        ya = afma(S1, cur.r[1], ya);
        yb = afma(S3, cur.r[3], yb);
        const float y = allreduce16(ya + yb);
        ykeep = (j == li) ? y : ykeep;
        __builtin_amdgcn_sched_barrier(0);
      }
      yout[(size_t)(t0 + j) * 512] = f2bf(ykeep);
      if (c + 1 < nchunks) lstore((cc + 1) & 1, stset);
      __syncthreads();
    }
  };
  for (int c4 = 0; c4 < nchunks; c4 += 4) {
    chunk(c4 + 0, 0, rg3, rg1);
    chunk(c4 + 1, 1, rg0, rg2);
    chunk(c4 + 2, 2, rg1, rg3);
    chunk(c4 + 3, 3, rg2, rg0);
  }
  if (ctx) {
    float* so = p.out + (d ? 13631488 : 12582912) + ((size_t)(b * 8 + h) * 64 + row) * 64 + 4 * j;
    *(f32x4*)so = (f32x4){S0, S1, S2, S3};
  }
}
constexpr int MS_STEP = 896, MS_BUF = 16 * MS_STEP, MS_ZERO = 2 * MS_BUF;
template <int DIR>
DEVINL void scan_unit_mfma(const Params& p, int T, int tokbase, int b, int h, bool ctx, char* lds) {
  constexpr int d = DIR;
  const int tid = tid_opaque(), lane = tid & 63, wv = tid >> 6;
  const int vr = lane & 15, q = lane >> 4;
  const int row = wv * 16 + vr;
  f32x4 S[4];
#pragma unroll
  for (int kt = 0; kt < 4; ++kt) S[kt] = (f32x4){0.f, 0.f, 0.f, 0.f};
  if (!ctx) {
    const float* s0 = (d ? p.st_b : p.st_f) + ((size_t)(b * 8 + h) * 64 + row) * 64 + 4 * q;
#pragma unroll
    for (int kt = 0; kt < 4; ++kt) S[kt] = *(const f32x4*)(s0 + 16 * kt);
  }
  const u16* ops_s = (const u16*)(p.ws + OFF_OPS_S);
  const u16* ops_d = (const u16*)(p.ws + OFF_OPS_D);
  u16* ybase = ybuf_ptr(p, d, (size_t)tokbase) + h * 64 + row;
  const int nchunks = T >> 4;
  if (tid < 16) *(uint4*)(lds + MS_ZERO + tid * 16) = make_uint4(0u, 0u, 0u, 0u);
  int fs[3], fw[3];
#pragma unroll
  for (int i = 0; i < 3; ++i) { int idx = tid + 256 * i; fs[i] = idx / 48; fw[i] = idx % 48; }
  uint4 ra[3];
  const char* gp[3];
  int gst[3];
#pragma unroll
  for (int i = 0; i < 3; ++i) {
    const size_t tok = (size_t)(tokbase + (d ? T - 16 : 0) + fs[i]);
    const u16* src = fw[i] < 24 ? ops_s + (tok * 8 + h) * 192 + fw[i] * 8
                                : ops_d + ((tok * 8 + h) * 2 + d) * 192 + (fw[i] - 24) * 8;
    gp[i] = (const char*)src;
    gst[i] = (fw[i] < 24 ? 16 * 8 * 192 * 2 : 16 * 8 * 2 * 192 * 2) * (d ? -1 : 1);
  }
  auto gload = [&](int c) __attribute__((always_inline)) {
    (void)c;
#pragma unroll
    for (int i = 0; i < 3; ++i) { ra[i] = *(const uint4*)gp[i]; gp[i] += gst[i]; }
  };
  auto lstore = [&](int buf) __attribute__((always_inline)) {
#pragma unroll
    for (int i = 0; i < 3; ++i) {
      char* st = lds + buf * MS_BUF + fs[i] * MS_STEP;
      const int ty = fw[i] >> 3, c = fw[i] & 7;
      if (ty < 2) {
        const int hi4 = ((c >> 1) & 1) * 4;
        const int p1 = ((c >> 2) * 4 + ((2 * c) & 3)) * 8 + hi4;
        const int p2 = ((c >> 2) * 4 + ((2 * c + 1) & 3)) * 8 + hi4;
        char* base = st + ty * 128;
        *(uint2*)(base + p1 * 2) = make_uint2(ra[i].x, ra[i].y);
        *(uint2*)(base + p2 * 2) = make_uint2(ra[i].z, ra[i].w);
      } else if (ty == 2) {
        *(uint4*)(st + 256 + c * 16) = ra[i];
      } else if (ty == 3) {
        float* wdst = (float*)(st + 640) + c * 8;
        *(float4*)wdst = make_float4(hlo(ra[i].x), hhi(ra[i].x), hlo(ra[i].y), hhi(ra[i].y));
        *(float4*)(wdst + 4) = make_float4(hlo(ra[i].z), hhi(ra[i].z), hlo(ra[i].w), hhi(ra[i].w));
      } else {
        const uint32_t flip = (ty == 5) ? 0x80008000u : 0u;
        u16* kdst = (u16*)(st + 384) + c * 16 + (ty == 5 ? 1 : 0);
        const uint32_t x0 = ra[i].x ^ flip, x1 = ra[i].y ^ flip, x2 = ra[i].z ^ flip, x3 = ra[i].w ^ flip;
        kdst[0] = (u16)(x0 & 0xFFFFu);  kdst[2] = (u16)(x0 >> 16);
        kdst[4] = (u16)(x1 & 0xFFFFu);  kdst[6] = (u16)(x1 >> 16);
        kdst[8] = (u16)(x2 & 0xFFFFu);  kdst[10] = (u16)(x2 >> 16);
        kdst[12] = (u16)(x3 & 0xFFFFu); kdst[14] = (u16)(x3 >> 16);
      }
    }
  };
  gload(0);
  lstore(0);
  __syncthreads();
  const int sel = lane & 3;
  const unsigned fragoff = (unsigned)q * 16u;
  const unsigned qmask = (q == 0) ? 0xFFFFFFFFu : 0u;
  const char* rprev = lds + MS_ZERO;
  float yk[4] = {0.f, 0.f, 0.f, 0.f};
  auto yflush = [&](int tprev0) {
#pragma unroll
    for (int a = 0; a < 4; ++a) ybase[(size_t)(tprev0 + 4 * a + q) * 512] = f2bf(yk[a]);
  };
  struct MOps { bf16x8 a0, a1; unsigned vv; uint32_t kdb[4]; };
  const bool sel0 = sel == 0, sel1 = sel == 1;
  auto mload = [&](const char* L, const char* rp) __attribute__((always_inline)) {
    MOps o;
    const unsigned offL = (unsigned)(L - lds) + fragoff, offR = (unsigned)(rp - lds) + 128u + fragoff;
    const unsigned aoff = sel0 ? offL : (sel1 ? offR : (unsigned)MS_ZERO);
    const char* aptr = lds + aoff;
    o.a0 = *(const bf16x8*)aptr;
    o.a1 = *(const bf16x8*)(aptr + 64);
    o.vv = *(const u16*)(L + 256 + row * 2);
#pragma unroll
    for (int kt = 0; kt < 4; ++kt) {
      o.kdb[kt] = *(const uint32_t*)(L + 384 + (16 * kt + vr) * 4);
    }
    return o;
  };
  for (int c = 0; c < nchunks; ++c) {
    const bool more = c + 1 < nchunks;
    if (more) gload(c + 1);
    const char* L0 = lds + (c & 1) * MS_BUF;
    MOps ring[2];
    ring[0] = mload(L0 + (d ? 15 : 0) * MS_STEP, rprev);
#pragma unroll
    for (int s = 0; s < 16; ++s) {
      const int li = d ? 15 - s : s;
      const char* L = L0 + li * MS_STEP;
      if (s < 15) ring[(s + 1) & 1] = mload(L0 + (d ? 14 - s : s + 1) * MS_STEP, L);
      f32x4 w4[4];
#pragma unroll
      for (int kt = 0; kt < 4; ++kt) w4[kt] = *(const f32x4*)(L + 640 + (16 * kt + 4 * q) * 4);
      __builtin_amdgcn_sched_barrier(0);
      const MOps& cur = ring[s & 1];
      uint4 pb0 = make_uint4(pack2bf(S[0][0], S[0][1]), pack2bf(S[0][2], S[0][3]), pack2bf(S[1][0], S[1][1]), pack2bf(S[1][2], S[1][3]));
      uint4 pb1 = make_uint4(pack2bf(S[2][0], S[2][1]), pack2bf(S[2][2], S[2][3]), pack2bf(S[3][0], S[3][1]), pack2bf(S[3][2], S[3][3]));
      f32x4 D = {0.f, 0.f, 0.f, 0.f};
      D = __builtin_amdgcn_mfma_f32_16x16x32_bf16(cur.a0, __builtin_bit_cast(bf16x8, pb0), D, 0, 0, 0);
      D = __builtin_amdgcn_mfma_f32_16x16x32_bf16(cur.a1, __builtin_bit_cast(bf16x8, pb1), D, 0, 0, 0);
      const float u = D[0], yprev = D[1];
      {
        const int pi = (s == 0) ? (d ? 0 : 15) : (d ? 16 - s : s - 1);
        yk[pi >> 2] = (q == (pi & 3)) ? yprev : yk[pi >> 2];
        if (s == 0 && c > 0) yflush(d ? T - 16 * c : 16 * (c - 1));
      }
      const uint32_t b3w = (cur.vv | (pack2bf(u, 0.f) << 16)) & qmask;
      const uint4 b3v = make_uint4(b3w, 0u, 0u, 0u);
      const bf16x8 B3 = __builtin_bit_cast(bf16x8, b3v);
#pragma unroll
      for (int kt = 0; kt < 4; ++kt) {
        const uint4 a3v = make_uint4(cur.kdb[kt] & qmask, 0u, 0u, 0u);
        const f32x4 C = S[kt] * w4[kt];
        S[kt] = __builtin_amdgcn_mfma_f32_16x16x32_bf16(__builtin_bit_cast(bf16x8, a3v), B3, C, 0, 0, 0);
      }
      rprev = L;
      __builtin_amdgcn_sched_barrier(0);
    }
    if (more) lstore((c + 1) & 1);
    __syncthreads();
  }
  {
    const char* aptr = (sel == 1) ? rprev + 128 + fragoff : lds + MS_ZERO;
    const bf16x8 a0 = *(const bf16x8*)aptr;
    const bf16x8 a1 = *(const bf16x8*)(aptr + 64);
    uint4 pb0 = make_uint4(pack2bf(S[0][0], S[0][1]), pack2bf(S[0][2], S[0][3]), pack2bf(S[1][0], S[1][1]), pack2bf(S[1][2], S[1][3]));
    uint4 pb1 = make_uint4(pack2bf(S[2][0], S[2][1]), pack2bf(S[2][2], S[2][3]), pack2bf(S[3][0], S[3][1]), pack2bf(S[3][2], S[3][3]));
    f32x4 D = {0.f, 0.f, 0.f, 0.f};
    D = __builtin_amdgcn_mfma_f32_16x16x32_bf16(a0, __builtin_bit_cast(bf16x8, pb0), D, 0, 0, 0);
    D = __builtin_amdgcn_mfma_f32_16x16x32_bf16(a1, __builtin_bit_cast(bf16x8, pb1), D, 0, 0, 0);
    const int pi = d ? 0 : 15;
    yk[pi >> 2] = (q == (pi & 3)) ? D[1] : yk[pi >> 2];
    yflush(d ? 0 : T - 16);
  }
  if (ctx) {
    float* so = p.out + (d ? 13631488 : 12582912) + ((size_t)(b * 8 + h) * 64 + row) * 64 + 4 * q;
#pragma unroll
    for (int kt = 0; kt < 4; ++kt) *(f32x4*)(so + 16 * kt) = S[kt];
  }
  __syncthreads();
}

DEVINL void scan_dispatch(const Params& p, int unit, char* lds) {
  int T, tokbase, b, h, d, qq;
  bool ctx;
  if (unit < 128) { qq = unit & 3; d = (unit >> 2) & 1; h = (unit >> 3) & 7; b = unit >> 6; T = 2048; tokbase = NCTX + b * 2048; ctx = false; }
  else { const int u = unit - 128; qq = u & 3; d = (u >> 2) & 1; h = (u >> 3) & 7; b = u >> 6; T = 256; tokbase = b * 256; ctx = true; }
  if (!ctx) __builtin_amdgcn_s_setprio(3);
  if (d) scan_unit<1>(p, T, tokbase, b, h, qq, ctx, lds);
  else scan_unit<0>(p, T, tokbase, b, h, qq, ctx, lds);
  if (!ctx) __builtin_amdgcn_s_setprio(0);
}

DEVINL void scan_dispatch_mfma(const Params& p, int unit, char* lds) {
  const bool ctx = unit >= 32;
  const int u = ctx ? unit - 32 : unit;
  const int d = u & 1, h = (u >> 1) & 7, b = u >> 4;
  const int T = ctx ? 256 : 2048;
  const int tokbase = ctx ? b * 256 : NCTX + b * 2048;
  if (d) scan_unit_mfma<1>(p, T, tokbase, b, h, ctx, lds);
  else scan_unit_mfma<0>(p, T, tokbase, b, h, ctx, lds);
}

DEVINL void post_item(const Params& p, int item, int lane) {
  const int r = lane & 15, q = lane >> 4;
  const u16* proj = (const u16*)(p.ws + OFF_PROJ);
  const u16* ops_s = (const u16*)(p.ws + OFF_OPS_S);
  const float* bonus = (const float*)(p.ws + OFF_BONUS);
  u16* mixed = (u16*)(p.ws + OFF_H);
  {
    const int tile = item >> 3, h = item & 7;
    const size_t m = (size_t)tile * 16 + r;
    float y[16];
    float sum = 0.f;
#pragma unroll
    for (int mt = 0; mt < 4; ++mt) {
      const int ch = h * 64 + 16 * mt + 4 * q;
      uint2 ya = *(const uint2*)(ybuf_ptr(p, 0, m) + ch);
      uint2 yb = *(const uint2*)(ybuf_ptr(p, 1, m) + ch);
      y[4 * mt + 0] = bflo(ya.x) + bflo(yb.x); y[4 * mt + 1] = bfhi(ya.x) + bfhi(yb.x); y[4 * mt + 2] = bflo(ya.y) + bflo(yb.y); y[4 * mt + 3] = bfhi(ya.y) + bfhi(yb.y);
      sum += y[4 * mt] + y[4 * mt + 1] + y[4 * mt + 2] + y[4 * mt + 3];
    }
    sum += __shfl_xor(sum, 16);
    sum += __shfl_xor(sum, 32);
    const float mean = sum * (1.f / 64.f);
    float var = 0.f;
#pragma unroll
    for (int i = 0; i < 16; ++i) { float dlt = y[i] - mean; var += dlt * dlt; }
    var += __shfl_xor(var, 16);
    var += __shfl_xor(var, 32);
    const float rstd = rsqrtf(var * (1.f / 64.f) + 64e-5f);
    const float bon = bonus[m * 8 + h];
#pragma unroll
    for (int mt = 0; mt < 4; ++mt) {
      const int c = 16 * mt + 4 * q, ch = h * 64 + c;
      float4 gg = *(const float4*)(p.gn_g + ch);
      float4 gb = *(const float4*)(p.gn_b + ch);
      uint2 vv = *(const uint2*)(ops_s + (m * 8 + h) * 192 + 128 + c);
      uint2 gr = *(const uint2*)(proj + m * NPROJ + 1664 + ch);
      float o0 = ((y[4 * mt + 0] - mean) * rstd * gg.x + gb.x + bon * bflo(vv.x)) * silu_f(bflo(gr.x));
      float o1 = ((y[4 * mt + 1] - mean) * rstd * gg.y + gb.y + bon * bfhi(vv.x)) * silu_f(bfhi(gr.x));
      float o2 = ((y[4 * mt + 2] - mean) * rstd * gg.z + gb.z + bon * bflo(vv.y)) * silu_f(bflo(gr.y));
      float o3 = ((y[4 * mt + 3] - mean) * rstd * gg.w + gb.w + bon * bfhi(vv.y)) * silu_f(bfhi(gr.y));
      *(uint2*)(mixed + kb_off(NTOK, (int)m, ch)) = pack4bf(o0, o1, o2, o3);
    }
  }
}
__device__ void phase5_latent(const Params& p) {
  const int tid = tid_opaque(), lane = tid & 63, w = tid >> 6;
  for (int it = blockIdx.x * 4 + w; it < 2048; it += gridDim.x * 4) post_item(p, 4096 + it, lane);
}

DEVINL void outproj_tile(const Params& p, int id, char* lds) {
  const u16* wot = (const u16*)(p.ws + OFF_WOT);
  const u16* mixed = (const u16*)(p.ws + OFF_H);
  const float* mod = (const float*)(p.ws + OFF_MOD);
  const float* rowtab = (const float*)(p.ws + OFF_ROWTAB);
  const float* coltab = (const float*)(p.ws + OFF_COLTAB);
  const float* xp = p.x_prompt; const float* xs = p.x_sample;
  float* out = p.out;
  {
    const int mg = id >> 6, rem = id & 63;
    const int nt = rem >> 3, mt = mg * 8 + (rem & 7);
    const int n0 = nt * 128, m0 = mt * 128;
    f32x4 acc[4][4];
    gemm_core(wot + (size_t)n0 * 64, (size_t)1024 * 128, mixed + (size_t)m0 * 64, (size_t)NTOK * 128, 16, lds, acc);
    const int tid = tid_opaque(), lane = tid & 63, w = tid >> 6, wp = w >> 1, wq = w & 1, fr = lane & 15, fq = lane >> 4;
    const bool lat = m0 >= NCTX;
    const int mi = lat ? 1 + ((m0 - NCTX) >> 11) : 0;
    const int nb = n0 + 64 * wp + 4 * fq;
    const int mb = m0 + 64 * wq + fr;
    float4 g4[4];
#pragma unroll
    for (int i = 0; i < 4; ++i) g4[i] = *(const float4*)(mod + mi * 3072 + 2048 + nb + 16 * i);
#pragma unroll
    for (int jh = 0; jh < 2; ++jh) {
      float4 x4[4][2], e4[4][2];
#pragma unroll
      for (int i = 0; i < 4; ++i)
#pragma unroll
        for (int jj = 0; jj < 2; ++jj) {
          const int m = mb + 16 * (2 * jh + jj), n = nb + 16 * i;
          if (!lat) {
            x4[i][jj] = *(const float4*)(xp + (size_t)m * 1024 + n);
            e4[i][jj] = make_float4(0.f, 0.f, 0.f, 0.f);
          } else {
            const int mp = m - NCTX, t = mp & 2047;
            x4[i][jj] = *(const float4*)(xs + (size_t)mp * 1024 + n);
            const float* e = n < 512 ? rowtab + (t >> 6) * 512 + n : coltab + (t & 63) * 512 + (n - 512);
            e4[i][jj] = *(const float4*)e;
          }
        }
#pragma unroll
      for (int i = 0; i < 4; ++i)
#pragma unroll
        for (int jj = 0; jj < 2; ++jj) {
          const int m = mb + 16 * (2 * jh + jj), n = nb + 16 * i;
          const f32x4 v = acc[i][2 * jh + jj];
          float4 o = make_float4(x4[i][jj].x + e4[i][jj].x + g4[i].x * v[0], x4[i][jj].y + e4[i][jj].y + g4[i].y * v[1],
                                 x4[i][jj].z + e4[i][jj].z + g4[i].z * v[2], x4[i][jj].w + e4[i][jj].w + g4[i].w * v[3]);
          *(float4*)(out + (size_t)m * 1024 + n) = o;
        }
    }
  }
}
__device__ void phase6_latent(const Params& p, char* lds) {
  constexpr int ID0 = 384, NTILES = 384;
  int first, step, last;
  if ((gridDim.x & 7) == 0) { const int per = NTILES / 8, x = blockIdx.x & 7; first = x * per + (blockIdx.x >> 3); step = gridDim.x >> 3; last = (x + 1) * per; }
  else { first = blockIdx.x; step = gridDim.x; last = NTILES; }
  for (int id = first; id < last; id += step) outproj_tile(p, ID0 + id, lds);
}

DEVINL void final_row(const Params& p, int m, int lane) {
  {
    float* rowp = p.out + (size_t)m * 1024;
    float4 v[4];
    float ss = 0.f;
#pragma unroll
    for (int i = 0; i < 4; ++i) {
      v[i] = *(const float4*)(rowp + lane * 4 + 256 * i);
      ss += v[i].x * v[i].x + v[i].y * v[i].y + v[i].z * v[i].z + v[i].w * v[i].w;
    }
    ss = wave_sum(ss);
    const float rstd = rsqrtf(ss * (1.f / 1024.f) + 1e-6f);
#pragma unroll
    for (int i = 0; i < 4; ++i) {
      float4 g4 = *(const float4*)(p.fng + lane * 4 + 256 * i);
      *(float4*)(rowp + lane * 4 + 256 * i) = make_float4(v[i].x * rstd * g4.x, v[i].y * rstd * g4.y, v[i].z * rstd * g4.z, v[i].w * rstd * g4.w);
    }
  }
}
__device__ void phase7_latent(const Params& p) {
  const int tid = tid_opaque(), lane = tid & 63, w = tid >> 6;
  for (int m = 6144 + blockIdx.x * 4 + w; m < NTOK; m += gridDim.x * 4) final_row(p, m, lane);
}

__device__ void phase4(const Params& p, char* lds) {
  const int tid = tid_opaque(), lane = tid & 63, w = tid >> 6;
  int* cnt = (int*)(p.ws + OFF_CNT);
  int role;
  if (gridDim.x == 512) {
    const int x = blockIdx.x & 7, i = blockIdx.x >> 3;
    const bool lat = i < 32 ? ((i & 3) == 0) : ((i & 3) == 2);
    role = lat ? x * 16 + (i >> 2) : (1 << 20);
  } else {
    role = next_unit(cnt + 1, lds);
  }
  if (role < 128) {
    scan_dispatch(p, role, lds);
  } else {
  XcdBarrier wb = xcd_barrier_post((unsigned*)(p.ws + OFF_BAR2), (volatile LAS unsigned*)(lds + 65536 + 32), gridDim.x - 128);
  int nst = 5;
  asm volatile("" : "+s"(nst));
  for (int stage = 0; stage < nst; ++stage) {
    const int nunits = stage == 0 ? 256 + 1024 : stage == 1 ? 512 + 128 : stage == 2 ? 1024 : 384;
    for (;;) {
      const int u = next_unit(cnt + 2 + stage, lds);
      if (u >= nunits) break;
      if (stage == 0) { if (u < 256) fnet_tile(p, false, u, lds); else prep_item(p, (u - 256) * 4 + w, lane); }
      else if (stage == 1) { if (u < 512) scan_dispatch_mfma(p, 32 + u, lds); else fnet_tile(p, true, u - 512, lds); }
      else if (stage == 2) post_item(p, u * 4 + w, lane);
      else if (stage == 3) outproj_tile(p, u, lds);
      else { const int m0 = u * 16 + w * 4; for (int i = 0; i < 4; ++i) final_row(p, m0 + i, lane); }
    }
    if (stage + 1 < nst) xcd_barrier(wb);
  }
  }
}

__global__ void __launch_bounds__(THREADS, 2) fwd_megakernel(Params p) {
  extern __shared__ __attribute__((aligned(16))) char lds[];
  if (p.use_cg) cg::this_grid().sync();
  if (threadIdx.x == 0) { *(uint4*)(lds + 65536 + 16) = make_uint4(0u, 0u, 0u, 0u); *(uint4*)(lds + 65536 + 32) = make_uint4(0u, 0u, 0u, 0u); }
  __syncthreads();
  XcdBarrier bar = xcd_barrier_post((unsigned*)(p.ws + OFF_BAR), (volatile LAS unsigned*)(lds + 65536 + 16), gridDim.x);
  phase0(p, lds);
  xcd_barrier(bar);
  phase1(p, lds);
  xcd_barrier(bar);
  phase2_all(p, lds);
  xcd_barrier(bar);
  phase3_latent(p);
  xcd_barrier(bar);
  phase4(p, lds);
  xcd_barrier(bar);
  phase5_latent(p);
  xcd_barrier(bar);
  phase6_latent(p, lds);
  xcd_barrier(bar);
  phase7_latent(p);
}

extern "C" void kernel_launch(void* const* d_in, const int* in_sizes, int n_in, void* d_out, int out_size, void* d_ws, size_t ws_size,
                              hipStream_t stream) {
  static int grid_blocks = 0;
  if (grid_blocks == 0) {
    if (n_in != 24 || ws_size < WS_NEED) {
      fprintf(stderr, "kernel_launch: need 24 inputs and >= %zu bytes of workspace (got %d, %zu)\n", (size_t)WS_NEED, n_in, ws_size);
      grid_blocks = -1;
      return;
    }
    int dev = 0, cus = 0, per_cu = 0;
    hipGetDevice(&dev);
    hipDeviceGetAttribute(&cus, hipDeviceAttributeMultiprocessorCount, dev);
    if (hipFuncSetAttribute((const void*)fwd_megakernel, hipFuncAttributeMaxDynamicSharedMemorySize, LDS_BYTES) != hipSuccess) {
      fprintf(stderr, "kernel_launch: hipFuncSetAttribute failed\n");
      grid_blocks = -1;
      return;
    }
    hipOccupancyMaxActiveBlocksPerMultiprocessor(&per_cu, (const void*)fwd_megakernel, THREADS, LDS_BYTES);
    if (per_cu < 1) { fprintf(stderr, "kernel_launch: occupancy query returned %d\n", per_cu); grid_blocks = -1; return; }
    if (per_cu > 2) per_cu = 2;
    grid_blocks = cus * per_cu;
  }
  if (grid_blocks < 0) return;
  hipMemsetAsync(d_ws, 0, ZERO_BYTES, stream);
  Params p{};
  const float* const* in = (const float* const*)d_in;
  p.x_prompt = in[0]; p.x_sample = in[1]; p.st_f = in[2]; p.st_b = in[3]; p.c = in[4]; p.c_ctx = in[5]; p.w_ada = in[6]; p.b_ada = in[7];
  p.norm_g = in[8]; p.w_in = in[9]; p.mu = in[10]; p.w0 = in[11]; p.w2 = in[12]; p.a0 = in[13]; p.a2 = in[14]; p.k_k = in[15]; p.k_a = in[16];
  p.r_k = in[17]; p.gn_g = in[18]; p.gn_b = in[19]; p.w_fnet = in[20]; p.b_fnet = in[21]; p.w_out = in[22]; p.fng = in[23];
  p.out = (float*)d_out;
  p.ws = (char*)d_ws;
  void* args[] = {&p};
  hipError_t e = hipLaunchCooperativeKernel((const void*)fwd_megakernel, dim3(grid_blocks), dim3(THREADS), args, LDS_BYTES, stream);
  if (e != hipSuccess) fprintf(stderr, "cooperative launch failed: %s (grid %d)\n", hipGetErrorString(e), grid_blocks);
}
```

```cpp
#include <hip/hip_runtime.h>
#include <hip/hip_cooperative_groups.h>
#include <cstdio>
#include <cstdint>
namespace cg = cooperative_groups;

#define DEVINL __device__ __forceinline__
typedef unsigned short u16;
typedef __attribute__((ext_vector_type(8))) short bf16x8;
typedef __attribute__((ext_vector_type(4))) float f32x4;
typedef __attribute__((ext_vector_type(2))) float f32x2;
typedef __attribute__((ext_vector_type(2))) __bf16 bf16x2v;

constexpr int NTOK = 12288;
constexpr int NCTX = 8192;
constexpr int NPROJ = 2688;
constexpr int NIN = 3712;
#ifndef LATENT_MFMA
#define LATENT_MFMA 0
#endif
constexpr int THREADS = 256;
constexpr int LDS_BYTES = 65536 + 256;

constexpr size_t OFF_MOD    = 0;
constexpr size_t OFF_CNT    = 36864;
constexpr size_t OFF_BAR    = 36864 + 256;
constexpr size_t OFF_BAR2   = OFF_BAR + 13824;
constexpr size_t ZERO_BYTES = 65536;
static_assert(OFF_BAR2 + 13824 <= ZERO_BYTES, "barrier words");
constexpr size_t OFF_WTIN   = 65536;
constexpr size_t OFF_WOT    = OFF_WTIN + 7602176;
constexpr size_t OFF_W2T    = OFF_WOT + 2097152;
constexpr size_t OFF_ROWTAB = OFF_W2T + 131072;
constexpr size_t OFF_COLTAB = OFF_ROWTAB + 65536;
constexpr size_t OFF_A256   = OFF_COLTAB + 131072;
constexpr size_t OFF_BONUS  = OFF_A256 + 262144;
constexpr size_t OFF_M      = OFF_BONUS + 393216;
constexpr size_t OFF_H      = 11534336;
constexpr size_t OFF_PROJ   = OFF_H + 25165824;
constexpr size_t OFF_OPS_S  = OFF_PROJ + 66060288;
constexpr size_t OFF_OPS_D  = OFF_OPS_S + 37748736;
constexpr size_t OFF_GTL    = OFF_OPS_D + 75497472;
constexpr size_t OFF_A2048  = OFF_GTL + 8388608;
constexpr size_t OFF_GTC    = OFF_A2048 + 16777216;
constexpr size_t OFF_YBUF   = OFF_GTC;
constexpr size_t WS_NEED    = OFF_YBUF + 16777216;
static_assert(OFF_M + 262144 <= OFF_H, "small region overflow");
static_assert(OFF_GTC + 16777216 <= WS_NEED, "alias");
static_assert(WS_NEED <= 268435456, "workspace");

struct Params {
  const float *x_prompt, *x_sample, *st_f, *st_b, *c, *c_ctx, *w_ada, *b_ada, *norm_g, *w_in, *mu, *w0, *w2, *a0, *a2,
      *k_k, *k_a, *r_k, *gn_g, *gn_b, *w_fnet, *b_fnet, *w_out, *fng;
  float* out;
  char* ws;
  int use_cg;
  int pad_;
};

DEVINL uint32_t pack2bf(float a, float b) {
  f32x2 v = {a, b};
  bf16x2v r = __builtin_convertvector(v, bf16x2v);
  return __builtin_bit_cast(uint32_t, r);
}
DEVINL u16 f2bf(float a) { return (u16)(pack2bf(a, 0.f) & 0xFFFFu); }
DEVINL uint2 pack4bf(float a, float b, float c, float d) { return make_uint2(pack2bf(a, b), pack2bf(c, d)); }
DEVINL float bflo(uint32_t w) { return __uint_as_float(w << 16); }
DEVINL float bfhi(uint32_t w) { return __uint_as_float(w & 0xFFFF0000u); }
DEVINL uint32_t pack2h(float a, float b) {
  _Float16 ha = (_Float16)a, hb = (_Float16)b;
  return (uint32_t)__builtin_bit_cast(u16, ha) | ((uint32_t)__builtin_bit_cast(u16, hb) << 16);
}
DEVINL float hlo(uint32_t w) { return (float)__builtin_bit_cast(_Float16, (u16)(w & 0xFFFFu)); }
DEVINL float hhi(uint32_t w) { return (float)__builtin_bit_cast(_Float16, (u16)(w >> 16)); }
DEVINL int tid_opaque() { int t = threadIdx.x; asm volatile("" : "+v"(t)); return t; }
DEVINL size_t kb_off(int R, int row, int k) { return ((size_t)(k >> 6) * R + row) * 64 + (k & 63); }
DEVINL float rcp_f(float x) { return __builtin_amdgcn_rcpf(x); }
DEVINL float sigmoid_f(float x) { return rcp_f(1.f + __expf(-x)); }
DEVINL float silu_f(float x) { return x * sigmoid_f(x); }
DEVINL float amul(float a, float b) { float r; asm("v_mul_f32 %0, %1, %2" : "=v"(r) : "v"(a), "v"(b)); return r; }
DEVINL float afma(float a, float b, float c) { float r; asm("v_fma_f32 %0, %1, %2, %3" : "=v"(r) : "v"(a), "v"(b), "v"(c)); return r; }
DEVINL float afnma(float a, float b, float c) { float r; asm("v_fma_f32 %0, -%1, %2, %3" : "=v"(r) : "v"(a), "v"(b), "v"(c)); return r; }
template <int CTRL>
DEVINL float dpp_f(float x) {
  return __int_as_float(__builtin_amdgcn_update_dpp(0, __float_as_int(x), CTRL, 0xF, 0xF, false));
}
DEVINL float allreduce16(float x) {
  x += dpp_f<0x128>(x);
  x += dpp_f<0x124>(x);
  x += dpp_f<0x122>(x);
  x += dpp_f<0x121>(x);
  return x;
}
DEVINL float wave_sum(float x) {
#pragma unroll
  for (int o = 32; o >= 1; o >>= 1) x += __shfl_xor(x, o);
  return x;
}


#define XB_TMO      128
#define XB_XCNT(j)  (256  + 64 * (j))
#define XB_XSUB(j)  (1280 + 64 * (j))
#define XB_XGEN(j)  (2304 + 64 * (j))
#define XB_TOP      3328
#define XB_TOPGEN   3392
#define XCD_BAR_WORDS 3456
#define XB_SPIN_CAP (1u << 22)
#define LAS __attribute__((address_space(3)))
DEVINL unsigned xb_ld(unsigned* p) { return __hip_atomic_load(p, __ATOMIC_RELAXED, __HIP_MEMORY_SCOPE_AGENT); }
DEVINL unsigned xb_add(unsigned* p, unsigned v) { return __hip_atomic_fetch_add(p, v, __ATOMIC_RELAXED, __HIP_MEMORY_SCOPE_AGENT); }
DEVINL unsigned xb_xcc_id() { return (unsigned)__builtin_amdgcn_s_getreg((3 << 11) | 20) & 0xFu; }
#define XB_SPIN(cond, bar) do { unsigned _sp = 0; while (cond) { __builtin_amdgcn_s_sleep(1); \
    if ((++_sp & 255u) == 0u) { if (xb_ld(&(bar)[XB_TMO])) break; if (_sp > XB_SPIN_CAP) { atomicAdd(&(bar)[XB_TMO], 1u); break; } } } } while (0)
struct XcdBarrier { unsigned* bar; unsigned x; volatile LAS unsigned* st; unsigned total; };
DEVINL XcdBarrier xcd_barrier_post(unsigned* bar, volatile LAS unsigned* st, unsigned total) {
  XcdBarrier b; b.bar = bar; b.x = xb_xcc_id(); b.st = st; b.total = total;
  if (threadIdx.x == 0) (void)xb_add(&bar[XB_XCNT(b.x)], 1u);
  return b;
}
DEVINL void xcd_barrier_complete(unsigned* bar, unsigned x, unsigned G, unsigned& nloc, unsigned& nx) {
  unsigned sum, cnt, mine, sp = 0u;
  for (;;) {
    sum = 0u; cnt = 0u; mine = 0u;
#pragma unroll
    for (unsigned j = 0; j < 16; ++j) { const unsigned c = xb_ld(&bar[XB_XCNT(j)]); sum += c; cnt += (c > 0u) ? 1u : 0u; mine = (j == x) ? c : mine; }
    if (sum == G) break;
    __builtin_amdgcn_s_sleep(1);
    if ((++sp & 255u) == 0u) { if (xb_ld(&bar[XB_TMO])) break; if (sp > XB_SPIN_CAP) { atomicAdd(&bar[XB_TMO], 1u); break; } }
  }
  nloc = mine > 0u ? mine : 1u; nx = cnt > 0u ? cnt : 1u;
}
DEVINL void xcd_barrier(const XcdBarrier& b) {
  asm volatile("s_waitcnt vmcnt(0)" ::: "memory");
  __syncthreads();
  if (threadIdx.x == 0) {
    unsigned* bar = b.bar;
    __builtin_amdgcn_s_waitcnt(0);
    unsigned nloc = b.st[0], nx = b.st[1];
    if (nloc == 0u) { xcd_barrier_complete(bar, b.x, b.total, nloc, nx); b.st[0] = nloc; b.st[1] = nx; }
    const unsigned old = xb_add(&bar[XB_XSUB(b.x)], 1u);
    const unsigned gen = old / nloc;
    if (old + 1u == (gen + 1u) * nloc) {
      __builtin_amdgcn_fence(__ATOMIC_RELEASE, "agent");
      asm volatile("s_waitcnt vmcnt(0)" ::: "memory");
      const unsigned og = xb_add(&bar[XB_TOP], 1u);
      const unsigned tg = og / nx;
      if (og + 1u == (tg + 1u) * nx) xb_add(&bar[XB_TOPGEN], 1u);
      else XB_SPIN(xb_ld(&bar[XB_TOPGEN]) == tg, bar);
      __builtin_amdgcn_fence(__ATOMIC_ACQUIRE, "agent");
      xb_add(&bar[XB_XGEN(b.x)], 1u);
      asm volatile("s_waitcnt vmcnt(0)" ::: "memory");
    } else {
      XB_SPIN(xb_ld(&bar[XB_XGEN(b.x)]) == gen, bar);
      __builtin_amdgcn_fence(__ATOMIC_ACQUIRE, "agent");
      asm volatile("s_waitcnt vmcnt(0)" ::: "memory");
    }
  }
  __syncthreads();
}

DEVINL u16* ybuf_ptr(const Params& p, int d, size_t m) {
  return m < (size_t)NCTX ? (u16*)(p.ws + OFF_YBUF) + ((size_t)d * NCTX + m) * 512
                          : (u16*)(p.out + 8388608) + ((size_t)d * 4096 + (m - NCTX)) * 512;
}
DEVINL void unit_done(int* ctr) {
  asm volatile("s_waitcnt vmcnt(0)" ::: "memory");
  __syncthreads();
  if (threadIdx.x == 0) {
    __builtin_amdgcn_fence(__ATOMIC_RELEASE, "agent");
    asm volatile("s_waitcnt vmcnt(0)" ::: "memory");
    (void)xb_add((unsigned*)ctr, 1u);
  }
}
DEVINL void wait_for(int* ctr, int target) {
  if (threadIdx.x == 0) {
    unsigned sp = 0;
    while ((int)xb_ld((unsigned*)ctr) < target) { __builtin_amdgcn_s_sleep(2); if (++sp > (1u << 24)) break; }
    __builtin_amdgcn_fence(__ATOMIC_ACQUIRE, "agent");
    asm volatile("s_waitcnt vmcnt(0)" ::: "memory");
  }
  __syncthreads();
}

#define GT_WAIT(n) asm volatile("s_waitcnt vmcnt(" #n ")" ::: "memory")
DEVINL void gemm_core(const u16* __restrict__ P, size_t ksp, const u16* __restrict__ Q, size_t ksq, int nk, char* lds, f32x4 (&acc)[4][4]) {
  const int tid = tid_opaque(), lane = tid & 63, w = tid >> 6, wp = w >> 1, wq = w & 1;
  const int fr = lane & 15, fq = lane >> 4;
#pragma unroll
  for (int i = 0; i < 4; ++i)
#pragma unroll
    for (int j = 0; j < 4; ++j) acc[i][j] = (f32x4){0.f, 0.f, 0.f, 0.f};
  const char* Pb = (const char*)P;
  const char* Qb = (const char*)Q;
  unsigned so[2];
#pragma unroll
  for (int k = 0; k < 2; ++k) {
    const int R = (2 * w + k) * 16 + (lane >> 2);
    const int c = (lane & 3) ^ ((R & 8) ? 3 : 0);
    so[k] = (unsigned)(R * 128 + c * 16);
  }
  const int nst = nk * 2;
  auto issue = [&](int st) {
    const size_t kb = (size_t)(st >> 1);
    const unsigned kh = (unsigned)(st & 1) * 64u;
    char* dstp = lds + (st & 3) * 16384 + (2 * w) * 1024;
    const char* ps = Pb + kb * ksp + kh;
    const char* qs = Qb + kb * ksq + kh;
    __builtin_amdgcn_global_load_lds((const unsigned*)(ps + so[0]), (unsigned*)(dstp), 16, 0, 0);
    __builtin_amdgcn_global_load_lds((const unsigned*)(ps + so[1]), (unsigned*)(dstp + 1024), 16, 0, 0);
    __builtin_amdgcn_global_load_lds((const unsigned*)(qs + so[0]), (unsigned*)(dstp + 8192), 16, 0, 0);
    __builtin_amdgcn_global_load_lds((const unsigned*)(qs + so[1]), (unsigned*)(dstp + 8192 + 1024), 16, 0, 0);
  };
  issue(0);
  issue(1);
  issue(2);
  const int sw = (fr & 8) ? 3 : 0;
  const int roff = fr * 64 + ((fq ^ sw) << 4);
  for (int st = 0; st < nst; ++st) {
    if (st + 2 < nst) GT_WAIT(8); else if (st + 1 < nst) GT_WAIT(4); else GT_WAIT(0);
    __builtin_amdgcn_s_barrier();
    if (st + 3 < nst) issue(st + 3);
    const char* bp = lds + (st & 3) * 16384;
    const char* bq = bp + 8192;
    bf16x8 a[4], b[4];
#pragma unroll
    for (int i = 0; i < 4; ++i) {
      a[i] = *(const bf16x8*)(bp + (64 * wp + 16 * i) * 64 + roff);
      b[i] = *(const bf16x8*)(bq + (64 * wq + 16 * i) * 64 + roff);
    }
#pragma unroll
    for (int i = 0; i < 4; ++i)
#pragma unroll
      for (int j = 0; j < 4; ++j) acc[i][j] = __builtin_amdgcn_mfma_f32_16x16x32_bf16(a[i], b[j], acc[i][j], 0, 0, 0);
  }
  __syncthreads();
}
template <class Epi>
DEVINL void gemm_tile(const u16* __restrict__ P, size_t ksp, const u16* __restrict__ Q, size_t ksq, int nk, char* lds, Epi epi) {
  f32x4 acc[4][4];
  gemm_core(P, ksp, Q, ksq, nk, lds, acc);
  const int tid = tid_opaque(), lane = tid & 63, w = tid >> 6, wp = w >> 1, wq = w & 1;
  const int fr = lane & 15, fq = lane >> 4;
#pragma unroll
  for (int i = 0; i < 4; ++i)
#pragma unroll
    for (int j = 0; j < 4; ++j) epi(64 * wp + 16 * i + 4 * fq, 64 * wq + 16 * j + fr, acc[i][j]);
}

DEVINL void transpose_unit(const float* __restrict__ src, int ld, int k0, int c0, u16* __restrict__ dst, int R, int n0, float* tile) {
  const int tid = tid_opaque();
#pragma unroll 4
  for (int i = 0; i < 16; ++i) {
    int kk = (tid >> 6) + 4 * i, nn = tid & 63;
    tile[kk * 65 + nn] = src[(size_t)(k0 + kk) * ld + c0 + nn];
  }
  __syncthreads();
#pragma unroll
  for (int i = 0; i < 2; ++i) {
    int nn = (tid >> 3) + 32 * i, kc = tid & 7;
    const float* t = tile + (kc * 8) * 65 + nn;
    uint4 o;
    o.x = pack2bf(t[0], t[65]);
    o.y = pack2bf(t[130], t[195]);
    o.z = pack2bf(t[260], t[325]);
    o.w = pack2bf(t[390], t[455]);
    *(uint4*)(dst + kb_off(R, n0 + nn, k0 + kc * 8)) = o;
  }
  __syncthreads();
}

__device__ void phase0(const Params& p, char* lds) {
  const int tid = tid_opaque();
  float* ldsf = (float*)lds;
  float* mod = (float*)(p.ws + OFF_MOD);
  constexpr int NU_M = 64, NU_MOD = 384, NU_TIN = 672, NU_TOUT = 256;
  constexpr int NU = NU_M + NU_MOD + NU_TIN + NU_TOUT;
  for (int u = blockIdx.x; u < NU; u += gridDim.x) {
    if (u < NU_M) {
      const int g = u >> 3, c8 = u & 7;
      float* tabc = ldsf; float* tabs = ldsf + 64;
      if (tid < 64) { float s, c; sincospif((float)tid * (1.f / 32.f), &s, &c); tabc[tid] = c; tabs[tid] = s; }
      __syncthreads();
      const int j2 = tid & 127, jj = j2 & 63;
      const float* tab = (j2 >> 6) ? tabs : tabc;
      const float* wf = p.w_fnet + (size_t)g * 4096 + jj;
      float* Mo = (float*)(p.ws + OFF_M) + (size_t)g * 8192;
      {
        const int cb = c8 * 8 + (tid >> 7);
        float s0 = 0.f, s1 = 0.f, s2 = 0.f, s3 = 0.f;
#pragma unroll 16
        for (int e = 0; e < 64; ++e) {
          const float wv = wf[e * 64];
          s0 += tab[(cb * e) & 63] * wv;
          s1 += tab[((cb + 2) * e) & 63] * wv;
          s2 += tab[((cb + 4) * e) & 63] * wv;
          s3 += tab[((cb + 6) * e) & 63] * wv;
        }
        Mo[cb * 128 + j2] = s0; Mo[(cb + 2) * 128 + j2] = s1; Mo[(cb + 4) * 128 + j2] = s2; Mo[(cb + 6) * 128 + j2] = s3;
      }
      __syncthreads();
    } else if (u < NU_M + NU_MOD) {
      const int v = u - NU_M;
      const int cb = v % 12, ks = v / 12;
      const int col = cb * 256 + tid;
      float a0 = 0.f, a1 = 0.f, a2 = 0.f;
      if (tid < 96) {
        const int kk = ks * 32 + (tid & 31), which = tid >> 5;
        const float cv = which == 0 ? p.c_ctx[kk] : p.c[(which - 1) * 1024 + kk];
        ldsf[tid] = silu_f(cv);
      }
      __syncthreads();
#pragma unroll 8
      for (int k = 0; k < 32; ++k) {
        float wv = p.w_ada[(size_t)(ks * 32 + k) * 3072 + col];
        a0 += ldsf[k] * wv;
        a1 += ldsf[32 + k] * wv;
        a2 += ldsf[64 + k] * wv;
      }
      __syncthreads();
      if (ks == 0) { float bb = p.b_ada[col]; a0 += bb; a1 += bb; a2 += bb; }
      unsafeAtomicAdd(&mod[col], a0);
      unsafeAtomicAdd(&mod[3072 + col], a1);
      unsafeAtomicAdd(&mod[6144 + col], a2);
    } else if (u < NU_M + NU_MOD + NU_TIN) {
      const int v = u - NU_M - NU_MOD;
      const int ktile = v & 15, ntile = v >> 4;
      const int n0 = ntile * 64;
      const int c0 = n0 < 2176 ? n0 : n0 + 512;
      transpose_unit(p.w_in, 3200, ktile * 64, c0, (u16*)(p.ws + OFF_WTIN), NIN, n0, ldsf);
    } else {
      const int v = u - NU_M - NU_MOD - NU_TIN;
      const int ktile = v & 15, ntile = v >> 4;
      transpose_unit(p.w_out, 1024, ktile * 64, ntile * 64, (u16*)(p.ws + OFF_WOT), 1024, ntile * 64, ldsf);
    }
  }
  const int gt = blockIdx.x * THREADS + tid, gn = gridDim.x * THREADS;
  {
    u16* w2t = (u16*)(p.ws + OFF_W2T);
    for (int i = gt; i < 65536; i += gn) {
      int j = i & 31, c = (i >> 5) & 511, combo = i >> 14;
      int d = combo >> 1;
      const float* src = (combo & 1) ? p.a2 : p.w2;
      w2t[i] = f2bf(src[((size_t)d * 32 + j) * 512 + c]);
    }
  }
  {
    float* rowtab = (float*)(p.ws + OFF_ROWTAB);
    float* coltab = (float*)(p.ws + OFF_COLTAB);
    for (int i = gt; i < 96 * 256; i += gn) {
      int f = i & 255, pos = i >> 8;
      float freq = expf(-9.210340371976184f * (float)f * (1.f / 256.f));
      float pv = pos < 32 ? (float)pos : (float)(pos - 32);
      float ang = pv * freq;
      float s = sinf(ang), c = cosf(ang);
      float* dst = pos < 32 ? rowtab + pos * 512 : coltab + (pos - 32) * 512;
      dst[f] = s; dst[256 + f] = c;
    }
  }
  {
    u16* a256 = (u16*)(p.ws + OFF_A256);
    for (int i = gt; i < 256 * 256; i += gn) {
      int k = i & 255, tp = i >> 8;
      int m = (tp * k) & 255;
      float s, c; sincospif((float)m * (1.f / 128.f), &s, &c);
      a256[kb_off(256, tp, k)] = f2bf(c);
      a256[kb_off(256, tp, 256 + k)] = f2bf(-s);
    }
    u16* a2048 = (u16*)(p.ws + OFF_A2048);
    __syncthreads();
    float* ctab = ldsf;
    for (int m = tid; m < 2048; m += THREADS) { float sn, cs; sincospif((float)m * (1.f / 1024.f), &sn, &cs); ctab[m] = cs; }
    __syncthreads();
    for (int i = gt; i < 2048 * 2048; i += gn) {
      int k = i & 2047, tp = i >> 11;
      int m = (tp * k) & 2047;
      a2048[kb_off(2048, tp, k)] = f2bf(ctab[m]);
      a2048[kb_off(2048, tp, 2048 + k)] = f2bf(-ctab[(m - 512) & 2047]);
    }
  }
}

__device__ void phase1(const Params& p, char* lds) {
  const int tid = tid_opaque(), lane = tid & 63, w = tid >> 6;
  float* ldsf = (float*)lds;
  const float* mod = (const float*)(p.ws + OFF_MOD);
  const float* rowtab = (const float*)(p.ws + OFF_ROWTAB);
  const float* coltab = (const float*)(p.ws + OFF_COLTAB);
  u16* hbuf = (u16*)(p.ws + OFF_H);
  constexpr int NU_FOLD = 512, NU_ROWS = NTOK / 4;
  for (int u = blockIdx.x; u < NU_FOLD + NU_ROWS; u += gridDim.x) {
    if (u < NU_FOLD) {
      const int g = u >> 6, k0 = ((u >> 2) & 15) * 64, jq = (u & 3) * 32;
      float* Ml = ldsf;
      float* Wl = ldsf + 2048;
      const float* Mg = (const float*)(p.ws + OFF_M) + (size_t)g * 8192 + jq;
      for (int i = tid; i < 512; i += THREADS) ((float4*)Ml)[i] = *(const float4*)(Mg + (i >> 3) * 128 + (i & 7) * 4);
#pragma unroll 4
      for (int i = 0; i < 16; ++i) {
        int kk = (tid >> 6) + 4 * i, cc = tid & 63;
        Wl[kk * 65 + cc] = p.w_in[(size_t)(k0 + kk) * 3200 + 2176 + g * 64 + cc];
      }
      __syncthreads();
      u16* dst = (u16*)(p.ws + OFF_WTIN);
      for (int grp = 0; grp < 2; ++grp) {
        const int jl = w * 8 + grp * 4;
        float s0 = 0.f, s1 = 0.f, s2 = 0.f, s3 = 0.f;
#pragma unroll 8
        for (int cc = 0; cc < 64; ++cc) {
          float wl = Wl[lane * 65 + cc];
          float4 m4 = *(const float4*)(Ml + cc * 32 + jl);
          s0 += wl * m4.x; s1 += wl * m4.y; s2 += wl * m4.z; s3 += wl * m4.w;
        }
        size_t o = kb_off(NIN, 2688 + g * 128 + jq + jl, k0 + lane);
        dst[o] = f2bf(s0); dst[o + 64] = f2bf(s1); dst[o + 128] = f2bf(s2); dst[o + 192] = f2bf(s3);
      }
      __syncthreads();
    } else {
      const int m = (u - NU_FOLD) * 4 + w;
      const bool lat = m >= NCTX;
      const int mp = m - NCTX;
      const int t = mp & 2047;
      const int mi = lat ? 1 + (mp >> 11) : 0;
      const float* xr = lat ? p.x_sample + (size_t)mp * 1024 : p.x_prompt + (size_t)m * 1024;
      float4 v[4];
      float ss = 0.f;
#pragma unroll
      for (int i = 0; i < 4; ++i) {
        const int col = lane * 4 + 256 * i;
        v[i] = *(const float4*)(xr + col);
        if (lat) {
          const float* e = col < 512 ? rowtab + (t >> 6) * 512 + col : coltab + (t & 63) * 512 + (col - 512);
          float4 e4 = *(const float4*)e;
          v[i].x += e4.x; v[i].y += e4.y; v[i].z += e4.z; v[i].w += e4.w;
        }
        ss += v[i].x * v[i].x + v[i].y * v[i].y + v[i].z * v[i].z + v[i].w * v[i].w;
      }
      ss = wave_sum(ss);
      const float rstd = rsqrtf(ss * (1.f / 1024.f) + 1e-6f);
#pragma unroll
      for (int i = 0; i < 4; ++i) {
        const int col = lane * 4 + 256 * i;
        float4 g4 = *(const float4*)(p.norm_g + col);
        float4 sh = *(const float4*)(mod + mi * 3072 + col);
        float4 sc = *(const float4*)(mod + mi * 3072 + 1024 + col);
        float h0 = v[i].x * rstd * g4.x * (1.f + sc.x) + sh.x;
        float h1 = v[i].y * rstd * g4.y * (1.f + sc.y) + sh.y;
        float h2 = v[i].z * rstd * g4.z * (1.f + sc.z) + sh.z;
        float h3 = v[i].w * rstd * g4.w * (1.f + sc.w) + sh.w;
        *(uint2*)(hbuf + kb_off(NTOK, m, col)) = pack4bf(h0, h1, h2, h3);
      }
    }
  }
}

DEVINL void inproj_tile(const Params& p, int id, char* lds) {
  const u16* hbuf = (const u16*)(p.ws + OFF_H);
  const u16* wt = (const u16*)(p.ws + OFF_WTIN);
  u16* proj = (u16*)(p.ws + OFF_PROJ);
  u16* gtc = (u16*)(p.ws + OFF_GTC);
  u16* gtl = (u16*)(p.ws + OFF_GTL);
  constexpr int NT = 29;
  constexpr size_t KS_W = (size_t)NIN * 128, KS_H = (size_t)NTOK * 128;
  const int mg = id / (NT * 8), rem = id % (NT * 8);
  const int nt = rem >> 3, mt = mg * 8 + (rem & 7);
  const int m0 = mt * 128, n0 = nt * 128;
  if (nt < 21) {
    f32x4 acc[4][4];
    gemm_core(wt + (size_t)n0 * 64, KS_W, hbuf + (size_t)m0 * 64, KS_H, 16, lds, acc);
    const int tid = tid_opaque(), lane = tid & 63, w = tid >> 6, wp = w >> 1, wq = w & 1, fr = lane & 15, fq = lane >> 4;
    constexpr int CST = 272;
#pragma unroll
    for (int i = 0; i < 4; ++i)
#pragma unroll
      for (int j = 0; j < 4; ++j) {
        const int ql = 64 * wq + 16 * j + fr, pl = 64 * wp + 16 * i + 4 * fq;
        *(uint2*)(lds + ql * CST + pl * 2) = pack4bf(acc[i][j][0], acc[i][j][1], acc[i][j][2], acc[i][j][3]);
      }
    __syncthreads();
#pragma unroll
    for (int k = 0; k < 8; ++k) {
      const int row = (tid >> 4) + 16 * k, c16 = tid & 15;
      const uint4 v = *(const uint4*)(lds + row * CST + c16 * 16);
      *(uint4*)(proj + (size_t)(m0 + row) * NPROJ + n0 + c16 * 8) = v;
    }
    __syncthreads();
  } else {
    const int g = nt - 21;
    f32x4 acc[4][4];
    gemm_core(hbuf + (size_t)m0 * 64, KS_H, wt + (size_t)n0 * 64, KS_W, 16, lds, acc);
    const int tid = tid_opaque(), lane = tid & 63, w = tid >> 6, wp = w >> 1, wq = w & 1, fr = lane & 15, fq = lane >> 4;
    constexpr int CST = 272;
#pragma unroll
    for (int i = 0; i < 4; ++i)
#pragma unroll
      for (int j = 0; j < 4; ++j) {
        const int ql = 64 * wq + 16 * j + fr, pl = 64 * wp + 16 * i + 4 * fq;
        *(uint2*)(lds + ql * CST + pl * 2) = pack4bf(acc[i][j][0], acc[i][j][1], acc[i][j][2], acc[i][j][3]);
      }
    __syncthreads();
    const bool isctx = m0 < NCTX;
    const int bb = isctx ? (m0 >> 8) : ((m0 - NCTX) >> 11);
    const int tb = isctx ? (m0 & 255) : ((m0 - NCTX) & 2047);
#pragma unroll
    for (int k = 0; k < 8; ++k) {
      const int row = (tid >> 4) + 16 * k, c16 = tid & 15;
      const uint4 v = *(const uint4*)(lds + row * CST + c16 * 16);
      const int part = row >> 6, cp = row & 63, t = tb + c16 * 8;
      u16* dst = isctx ? gtc + kb_off(16384, (bb * 8 + g) * 64 + cp, part * 256 + t)
                       : gtl + kb_off(1024, (bb * 8 + g) * 64 + cp, part * 2048 + t);
      *(uint4*)dst = v;
    }
    __syncthreads();
  }
}
__device__ void phase2_all(const Params& p, char* lds) {
  constexpr int NTILES = 29 * 96;
  int first, step, last;
  if ((gridDim.x & 7) == 0) { const int per = NTILES / 8, x = blockIdx.x & 7; first = x * per + (blockIdx.x >> 3); step = gridDim.x >> 3; last = (x + 1) * per; }
  else { first = blockIdx.x; step = gridDim.x; last = NTILES; }
  for (int id = first; id < last; id += step) inproj_tile(p, id, lds);
}

DEVINL void mix4(const u16* prow, bool hasPrev, bool hasNext, const float* mu, int col, float* o) {
  uint2 c = *(const uint2*)(prow + col);
  uint2 pv = make_uint2(0u, 0u), nx = make_uint2(0u, 0u);
  if (hasPrev) pv = *(const uint2*)(prow - NPROJ + col);
  if (hasNext) nx = *(const uint2*)(prow + NPROJ + col);
  float4 m4 = *(const float4*)(mu + col);
  float c0 = bflo(c.x), c1 = bfhi(c.x), c2 = bflo(c.y), c3 = bfhi(c.y);
  o[0] = c0 + m4.x * (0.5f * (bflo(pv.x) + bflo(nx.x)) - c0);
  o[1] = c1 + m4.y * (0.5f * (bfhi(pv.x) + bfhi(nx.x)) - c1);
  o[2] = c2 + m4.z * (0.5f * (bflo(pv.y) + bflo(nx.y)) - c2);
  o[3] = c3 + m4.w * (0.5f * (bfhi(pv.y) + bfhi(nx.y)) - c3);
}
DEVINL void mix8(const u16* prow, bool hasPrev, bool hasNext, const float* mu, int col, float* o) {
  mix4(prow, hasPrev, hasNext, mu, col, o);
  mix4(prow, hasPrev, hasNext, mu, col + 4, o + 4);
}
DEVINL float tanh_f(float x) {
  float e = __expf(2.f * x);
  return 1.f - 2.f * rcp_f(e + 1.f);
}

DEVINL void prep_item(const Params& p, int item, int lane) {
  const int tile = item >> 3, h = item & 7;
  const int r = lane & 15, q = lane >> 4;
  const int m = tile * 16 + r;
  int T, t;
  if (m < NCTX) { T = 256; t = m & 255; } else { T = 2048; t = (m - NCTX) & 2047; }
  const bool hasPrev = t > 0, hasNext = t < T - 1;
  const u16* prow = (const u16*)(p.ws + OFF_PROJ) + (size_t)m * NPROJ;
  const u16* w2t = (const u16*)(p.ws + OFF_W2T);
  u16* ops_s = (u16*)(p.ws + OFF_OPS_S) + ((size_t)m * 8 + h) * 192;
  u16* ops_d = (u16*)(p.ws + OFF_OPS_D) + ((size_t)m * 8 + h) * 384;

  bf16x8 xw[2], xa[2];
#pragma unroll
  for (int d = 0; d < 2; ++d) {
    float t8[8];
    mix8(prow, hasPrev, hasNext, p.mu, 1536 + d * 32 + 8 * q, t8);
#pragma unroll
    for (int e = 0; e < 8; ++e) t8[e] = tanh_f(t8[e]);
    uint4 pk = make_uint4(pack2bf(t8[0], t8[1]), pack2bf(t8[2], t8[3]), pack2bf(t8[4], t8[5]), pack2bf(t8[6], t8[7]));
    xw[d] = __builtin_bit_cast(bf16x8, pk);
    mix8(prow, hasPrev, hasNext, p.mu, 1600 + d * 32 + 8 * q, t8);
    pk = make_uint4(pack2bf(t8[0], t8[1]), pack2bf(t8[2], t8[3]), pack2bf(t8[4], t8[5]), pack2bf(t8[6], t8[7]));
    xa[d] = __builtin_bit_cast(bf16x8, pk);
  }
  float nsq = 0.f;
#pragma unroll 4
  for (int mt = 0; mt < 4; ++mt) {
    const int ch = h * 64 + 16 * mt + 4 * q;
    float kp[4];
    mix4(prow, hasPrev, hasNext, p.mu, 512 + ch, kp);
    float4 kk4 = *(const float4*)(p.k_k + ch);
    float a0 = kp[0] * kk4.x, a1 = kp[1] * kk4.y, a2 = kp[2] * kk4.z, a3 = kp[3] * kk4.w;
    nsq += a0 * a0 + a1 * a1 + a2 * a2 + a3 * a3;
  }
  nsq += __shfl_xor(nsq, 16);
  nsq += __shfl_xor(nsq, 32);
  const float inv = 1.f / fmaxf(sqrtf(nsq), 1e-12f);
  float bon = 0.f;
#pragma unroll 1
  for (int mt = 0; mt < 4; ++mt) {
    const int c = 16 * mt + 4 * q;
    const int ch = h * 64 + c;
    float rp[4], vp[4], kk[4], kp[4];
    mix4(prow, hasPrev, hasNext, p.mu, 512 + ch, kp);
    mix4(prow, hasPrev, hasNext, p.mu, ch, rp);
    mix4(prow, hasPrev, hasNext, p.mu, 1024 + ch, vp);
    {
      float4 kk4 = *(const float4*)(p.k_k + ch);
      kk[0] = kp[0] * kk4.x * inv; kk[1] = kp[1] * kk4.y * inv; kk[2] = kp[2] * kk4.z * inv; kk[3] = kp[3] * kk4.w * inv;
    }
    *(uint2*)(ops_s + c) = pack4bf(kk[0], kk[1], kk[2], kk[3]);
    *(uint2*)(ops_s + 64 + c) = pack4bf(rp[0], rp[1], rp[2], rp[3]);
    *(uint2*)(ops_s + 128 + c) = pack4bf(vp[0], vp[1], vp[2], vp[3]);
    const float4 ka4 = *(const float4*)(p.k_a + ch);
    const float4 rk4 = *(const float4*)(p.r_k + ch);
    const float kav[4] = {ka4.x, ka4.y, ka4.z, ka4.w};
    const float rkv[4] = {rk4.x, rk4.y, rk4.z, rk4.w};
#pragma unroll
    for (int d = 0; d < 2; ++d) {
      bf16x8 aw = *(const bf16x8*)(w2t + ((size_t)((d * 2 + 0) * 512 + h * 64 + 16 * mt + r)) * 32 + 8 * q);
      bf16x8 aa = *(const bf16x8*)(w2t + ((size_t)((d * 2 + 1) * 512 + h * 64 + 16 * mt + r)) * 32 + 8 * q);
      f32x4 z0 = {0.f, 0.f, 0.f, 0.f};
      f32x4 zw = __builtin_amdgcn_mfma_f32_16x16x32_bf16(aw, xw[d], z0, 0, 0, 0);
      f32x4 za = __builtin_amdgcn_mfma_f32_16x16x32_bf16(aa, xa[d], z0, 0, 0, 0);
      const float4 w04 = *(const float4*)(p.w0 + d * 512 + ch);
      const float4 a04 = *(const float4*)(p.a0 + d * 512 + ch);
      const float w0v[4] = {w04.x, w04.y, w04.z, w04.w};
      const float a0v[4] = {a04.x, a04.y, a04.z, a04.w};
      float wd[4], kd[4], bb[4];
#pragma unroll
      for (int i = 0; i < 4; ++i) {
        float sg = sigmoid_f(zw[i] + w0v[i]);
        wd[i] = __expf(-0.6065306597126334f * sg);
        float av = sigmoid_f(za[i] + a0v[i]);
        kd[i] = kp[i] * (1.f + (av - 1.f) * kav[i]);
        bb[i] = kk[i] * av;
        bon += rp[i] * kd[i] * rkv[i];
      }
      u16* pd = ops_d + d * 192;
      *(uint2*)(pd + c) = make_uint2(pack2h(wd[0], wd[1]), pack2h(wd[2], wd[3]));
      *(uint2*)(pd + 64 + c) = pack4bf(kd[0], kd[1], kd[2], kd[3]);
      *(uint2*)(pd + 128 + c) = pack4bf(bb[0], bb[1], bb[2], bb[3]);
    }
  }
  bon += __shfl_xor(bon, 16);
  bon += __shfl_xor(bon, 32);
  if (q == 0) ((float*)(p.ws + OFF_BONUS))[(size_t)m * 8 + h] = bon;
}

DEVINL void fnet_tile(const Params& p, bool latn, int u, char* lds) {
  const int tid = tid_opaque(), lane = tid & 63, w = tid >> 6;
  const u16* proj = (const u16*)(p.ws + OFF_PROJ);
  u16* mixed = (u16*)(p.ws + OFF_H);
  {
      int p0, q0; size_t mbase; float scale;
      f32x4 acc[4][4];
      if (latn) {
        p0 = (u & 7) * 128; q0 = (u >> 3) * 128;
        scale = 0.002762135864009951f;
        mbase = NCTX + (size_t)(p0 >> 9) * 2048 + q0;
        gemm_core((const u16*)(p.ws + OFF_GTL) + (size_t)p0 * 64, (size_t)1024 * 128, (const u16*)(p.ws + OFF_A2048) + (size_t)q0 * 64, (size_t)2048 * 128, 64, lds, acc);
      } else {
        const int v0 = u;
        p0 = (v0 >> 1) * 128; q0 = (v0 & 1) * 128;
        scale = 0.0078125f;
        mbase = (size_t)(p0 >> 9) * 256 + q0;
        gemm_core((const u16*)(p.ws + OFF_GTC) + (size_t)p0 * 64, (size_t)16384 * 128, (const u16*)(p.ws + OFF_A256) + (size_t)q0 * 64, (size_t)256 * 128, 8, lds, acc);
      }
      const int wp = w >> 1, wq = w & 1, fr = lane & 15, fq = lane >> 4;
      const int gc0 = (p0 & 511) + 64 * wp + 4 * fq;
      const size_t m0 = mbase + 64 * wq + fr;
      uint2 gf[4][4];
      float4 b4[4];
#pragma unroll
      for (int i = 0; i < 4; ++i) {
        b4[i] = *(const float4*)(p.b_fnet + gc0 + 16 * i);
#pragma unroll
        for (int j = 0; j < 4; ++j) gf[i][j] = *(const uint2*)(proj + (m0 + 16 * j) * NPROJ + 2176 + gc0 + 16 * i);
      }
#pragma unroll
      for (int i = 0; i < 4; ++i)
#pragma unroll
        for (int j = 0; j < 4; ++j) {
          const f32x4 v = acc[i][j];
          float o0 = (v[0] * scale + b4[i].x) * silu_f(bflo(gf[i][j].x));
          float o1 = (v[1] * scale + b4[i].y) * silu_f(bfhi(gf[i][j].x));
          float o2 = (v[2] * scale + b4[i].z) * silu_f(bflo(gf[i][j].y));
          float o3 = (v[3] * scale + b4[i].w) * silu_f(bfhi(gf[i][j].y));
          *(uint2*)(mixed + kb_off(NTOK, (int)(m0 + 16 * j), 512 + gc0 + 16 * i)) = pack4bf(o0, o1, o2, o3);
        }
  }
}

DEVINL int next_unit(int* counter, char* lds) {
  volatile int* slot = (volatile int*)(lds + 65536);
  __syncthreads();
  if (threadIdx.x == 0) *slot = atomicAdd(counter, 1);
  __syncthreads();
  return *slot;
}

__device__ void phase3_latent(const Params& p) {
  const int tid = tid_opaque(), lane = tid & 63, w = tid >> 6;
  for (int it = blockIdx.x * 4 + w; it < 2048; it += gridDim.x * 4) prep_item(p, 4096 + it, lane);
}

struct StepOps { f32x4 kk, r, w, kd, b; float v; };
DEVINL StepOps load_ops(const float* L, int j, int row) {
  StepOps o;
  o.kk = *(const f32x4*)(L + 4 * j);
  o.r = *(const f32x4*)(L + 64 + 4 * j);
  o.v = L[128 + row];
  o.w = *(const f32x4*)(L + 192 + 4 * j);
  o.kd = *(const f32x4*)(L + 256 + 4 * j);
  o.b = *(const f32x4*)(L + 320 + 4 * j);
  return o;
}
template <int DIR>
DEVINL void scan_unit(const Params& p, int T, int tokbase, int b, int h, int qq, bool ctx, char* lds) {
  constexpr int d = DIR;
  const int tid = tid_opaque(), lane = tid & 63, w = tid >> 6;
  const int g = lane >> 4, j = lane & 15;
  const int row = qq * 16 + w * 4 + g;
  float S0 = 0.f, S1 = 0.f, S2 = 0.f, S3 = 0.f;
  if (!ctx) {
    const float* s0 = (d ? p.st_b : p.st_f) + ((size_t)(b * 8 + h) * 64 + row) * 64 + 4 * j;
    f32x4 s4 = *(const f32x4*)s0;
    S0 = s4[0]; S1 = s4[1]; S2 = s4[2]; S3 = s4[3];
  }
  const u16* ops_s = (const u16*)(p.ws + OFF_OPS_S);
  const u16* ops_d = (const u16*)(p.ws + OFF_OPS_D);
  float* ldsf = (float*)lds;
  u16* yout = ybuf_ptr(p, d, (size_t)tokbase) + h * 64 + row;
  const int nchunks = T >> 4;
  int ps[3], pw[3];
#pragma unroll
  for (int i = 0; i < 3; ++i) { int pi = tid + 256 * i; ps[i] = pi / 48; pw[i] = pi % 48; }
  uint4 rg0[3], rg1[3], rg2[3], rg3[3];
  const char* gp[3];
  int gst[3];
#pragma unroll
  for (int i = 0; i < 3; ++i) {
    const size_t tok = (size_t)(tokbase + (d ? T - 16 : 0) + ps[i]);
    const u16* src = pw[i] < 24 ? ops_s + (tok * 8 + h) * 192 + pw[i] * 8
                                : ops_d + ((tok * 8 + h) * 2 + d) * 192 + (pw[i] - 24) * 8;
    gp[i] = (const char*)src;
    gst[i] = (pw[i] < 24 ? 16 * 8 * 192 * 2 : 16 * 8 * 2 * 192 * 2) * (d ? -1 : 1);
  }
  auto gload = [&](int c, uint4 (&r)[3]) __attribute__((always_inline)) {
    (void)c;
#pragma unroll
    for (int i = 0; i < 3; ++i) { r[i] = *(const uint4*)gp[i]; gp[i] += gst[i]; }
  };
  auto lstore = [&](int buf, const uint4 (&r)[3]) __attribute__((always_inline)) {
#pragma unroll
    for (int i = 0; i < 3; ++i) {
      float* dst = ldsf + buf * 6144 + ps[i] * 384 + pw[i] * 8;
      float4 a, bq;
      if (pw[i] >= 24 && pw[i] < 32) {
        a = make_float4(hlo(r[i].x), hhi(r[i].x), hlo(r[i].y), hhi(r[i].y));
        bq = make_float4(hlo(r[i].z), hhi(r[i].z), hlo(r[i].w), hhi(r[i].w));
      } else {
        a = make_float4(bflo(r[i].x), bfhi(r[i].x), bflo(r[i].y), bfhi(r[i].y));
        bq = make_float4(bflo(r[i].z), bfhi(r[i].z), bflo(r[i].w), bfhi(r[i].w));
      }
      *(float4*)dst = a;
      *(float4*)(dst + 4) = bq;
    }
  };
  gload(0, rg0);
  gload(1, rg1);
  gload(2, rg2);
  lstore(0, rg0);
  __syncthreads();
  auto chunk = [&](const int c, const int cc, uint4 (&ldset)[3], const uint4 (&stset)[3]) __attribute__((always_inline)) {
    {
      if (c + 3 < nchunks) gload(c + 3, ldset);
      const float* L0 = ldsf + (cc & 1) * 6144;
      const int t0 = d ? T - 16 * (c + 1) : 16 * c;
      StepOps ring[3];
      ring[0] = load_ops(L0 + (d ? 15 : 0) * 384, j, row);
      ring[1] = load_ops(L0 + (d ? 14 : 1) * 384, j, row);
      float ykeep = 0.f;
#pragma unroll
      for (int s = 0; s < 16; ++s) {
        const int li = d ? 15 - s : s;
        if (s + 2 < 16) ring[(s + 2) % 3] = load_ops(L0 + (d ? 13 - s : s + 2) * 384, j, row);
        __builtin_amdgcn_sched_barrier(0);
        const StepOps& cur = ring[s % 3];
        float ua = amul(S0, cur.kk[0]);
        float ub = amul(S2, cur.kk[2]);
        ua = afma(S1, cur.kk[1], ua);
        ub = afma(S3, cur.kk[3], ub);
        const float u = allreduce16(ua + ub);
        float t0 = amul(cur.v, cur.kd[0]), t1 = amul(cur.v, cur.kd[1]), t2 = amul(cur.v, cur.kd[2]), t3 = amul(cur.v, cur.kd[3]);
        t0 = afnma(u, cur.b[0], t0); t1 = afnma(u, cur.b[1], t1); t2 = afnma(u, cur.b[2], t2); t3 = afnma(u, cur.b[3], t3);
        S0 = afma(S0, cur.w[0], t0); S1 = afma(S1, cur.w[1], t1); S2 = afma(S2, cur.w[2], t2); S3 = afma(S3, cur.w[3], t3);
        float ya = amul(S0, cur.r[0]);
        float yb = amul(S2, cur.r[2]);
        ya = afma(S1, cur.r[1], ya);
        yb = afma(S3, cur.r[3], yb);
        const float y = allreduce16(ya + yb);
        ykeep = (j == li) ? y : ykeep;
        __builtin_amdgcn_sched_barrier(0);
      }
      yout[(size_t)(t0 + j) * 512] = f2bf(ykeep);
      if (c + 1 < nchunks) lstore((cc + 1) & 1, stset);
      __syncthreads();
    }
  };
  for (int c4 = 0; c4 < nchunks; c4 += 4) {
    chunk(c4 + 0, 0, rg3, rg1);
    chunk(c4 + 1, 1, rg0, rg2);
    chunk(c4 + 2, 2, rg1, rg3);
    chunk(c4 + 3, 3, rg2, rg0);
  }
  if (ctx) {
    float* so = p.out + (d ? 13631488 : 12582912) + ((size_t)(b * 8 + h) * 64 + row) * 64 + 4 * j;
    *(f32x4*)so = (f32x4){S0, S1, S2, S3};
  }
}
constexpr int MS_STEP = 896, MS_BUF = 16 * MS_STEP, MS_ZERO = 2 * MS_BUF;
template <int DIR>
DEVINL void scan_unit_mfma(const Params& p, int T, int tokbase, int b, int h, bool ctx, char* lds) {
  constexpr int d = DIR;
  const int tid = tid_opaque(), lane = tid & 63, wv = tid >> 6;
  const int vr = lane & 15, q = lane >> 4;
  const int row = wv * 16 + vr;
  f32x4 S[4];
#pragma unroll
  for (int kt = 0; kt < 4; ++kt) S[kt] = (f32x4){0.f, 0.f, 0.f, 0.f};
  if (!ctx) {
    const float* s0 = (d ? p.st_b : p.st_f) + ((size_t)(b * 8 + h) * 64 + row) * 64 + 4 * q;
#pragma unroll
    for (int kt = 0; kt < 4; ++kt) S[kt] = *(const f32x4*)(s0 + 16 * kt);
  }
  const u16* ops_s = (const u16*)(p.ws + OFF_OPS_S);
  const u16* ops_d = (const u16*)(p.ws + OFF_OPS_D);
  u16* ybase = ybuf_ptr(p, d, (size_t)tokbase) + h * 64 + row;
  const int nchunks = T >> 4;
  if (tid < 16) *(uint4*)(lds + MS_ZERO + tid * 16) = make_uint4(0u, 0u, 0u, 0u);
  int fs[3], fw[3];
#pragma unroll
  for (int i = 0; i < 3; ++i) { int idx = tid + 256 * i; fs[i] = idx / 48; fw[i] = idx % 48; }
  uint4 ra[3];
  const char* gp[3];
  int gst[3];
#pragma unroll
  for (int i = 0; i < 3; ++i) {
    const size_t tok = (size_t)(tokbase + (d ? T - 16 : 0) + fs[i]);
    const u16* src = fw[i] < 24 ? ops_s + (tok * 8 + h) * 192 + fw[i] * 8
                                : ops_d + ((tok * 8 + h) * 2 + d) * 192 + (fw[i] - 24) * 8;
    gp[i] = (const char*)src;
    gst[i] = (fw[i] < 24 ? 16 * 8 * 192 * 2 : 16 * 8 * 2 * 192 * 2) * (d ? -1 : 1);
  }
  auto gload = [&](int c) __attribute__((always_inline)) {
    (void)c;
#pragma unroll
    for (int i = 0; i < 3; ++i) { ra[i] = *(const uint4*)gp[i]; gp[i] += gst[i]; }
  };
  auto lstore = [&](int buf) __attribute__((always_inline)) {
#pragma unroll
    for (int i = 0; i < 3; ++i) {
      char* st = lds + buf * MS_BUF + fs[i] * MS_STEP;
      const int ty = fw[i] >> 3, c = fw[i] & 7;
      if (ty < 2) {
        const int hi4 = ((c >> 1) & 1) * 4;
        const int p1 = ((c >> 2) * 4 + ((2 * c) & 3)) * 8 + hi4;
        const int p2 = ((c >> 2) * 4 + ((2 * c + 1) & 3)) * 8 + hi4;
        char* base = st + ty * 128;
        *(uint2*)(base + p1 * 2) = make_uint2(ra[i].x, ra[i].y);
        *(uint2*)(base + p2 * 2) = make_uint2(ra[i].z, ra[i].w);
      } else if (ty == 2) {
        *(uint4*)(st + 256 + c * 16) = ra[i];
      } else if (ty == 3) {
        float* wdst = (float*)(st + 640) + c * 8;
        *(float4*)wdst = make_float4(hlo(ra[i].x), hhi(ra[i].x), hlo(ra[i].y), hhi(ra[i].y));
        *(float4*)(wdst + 4) = make_float4(hlo(ra[i].z), hhi(ra[i].z), hlo(ra[i].w), hhi(ra[i].w));
      } else {
        const uint32_t flip = (ty == 5) ? 0x80008000u : 0u;
        u16* kdst = (u16*)(st + 384) + c * 16 + (ty == 5 ? 1 : 0);
        const uint32_t x0 = ra[i].x ^ flip, x1 = ra[i].y ^ flip, x2 = ra[i].z ^ flip, x3 = ra[i].w ^ flip;
        kdst[0] = (u16)(x0 & 0xFFFFu);  kdst[2] = (u16)(x0 >> 16);
        kdst[4] = (u16)(x1 & 0xFFFFu);  kdst[6] = (u16)(x1 >> 16);
        kdst[8] = (u16)(x2 & 0xFFFFu);  kdst[10] = (u16)(x2 >> 16);
        kdst[12] = (u16)(x3 & 0xFFFFu); kdst[14] = (u16)(x3 >> 16);
      }
    }
  };
  gload(0);
  lstore(0);
  __syncthreads();
  const int sel = lane & 3;
  const unsigned fragoff = (unsigned)q * 16u;
  const unsigned qmask = (q == 0) ? 0xFFFFFFFFu : 0u;
  const char* rprev = lds + MS_ZERO;
  float yk[4] = {0.f, 0.f, 0.f, 0.f};
  auto yflush = [&](int tprev0) {
#pragma unroll
    for (int a = 0; a < 4; ++a) ybase[(size_t)(tprev0 + 4 * a + q) * 512] = f2bf(yk[a]);
  };
  struct MOps { bf16x8 a0, a1; unsigned vv; uint32_t kdb[4]; };
  const bool sel0 = sel == 0, sel1 = sel == 1;
  auto mload = [&](const char* L, const char* rp) __attribute__((always_inline)) {
    MOps o;
    const unsigned offL = (unsigned)(L - lds) + fragoff, offR = (unsigned)(rp - lds) + 128u + fragoff;
    const unsigned aoff = sel0 ? offL : (sel1 ? offR : (unsigned)MS_ZERO);
    const char* aptr = lds + aoff;
    o.a0 = *(const bf16x8*)aptr;
    o.a1 = *(const bf16x8*)(aptr + 64);
    o.vv = *(const u16*)(L + 256 + row * 2);
#pragma unroll
    for (int kt = 0; kt < 4; ++kt) {
      o.kdb[kt] = *(const uint32_t*)(L + 384 + (16 * kt + vr) * 4);
    }
    return o;
  };
  for (int c = 0; c < nchunks; ++c) {
    const bool more = c + 1 < nchunks;
    if (more) gload(c + 1);
    const char* L0 = lds + (c & 1) * MS_BUF;
    MOps ring[2];
    ring[0] = mload(L0 + (d ? 15 : 0) * MS_STEP, rprev);
#pragma unroll
    for (int s = 0; s < 16; ++s) {
      const int li = d ? 15 - s : s;
      const char* L = L0 + li * MS_STEP;
      if (s < 15) ring[(s + 1) & 1] = mload(L0 + (d ? 14 - s : s + 1) * MS_STEP, L);
      f32x4 w4[4];
#pragma unroll
      for (int kt = 0; kt < 4; ++kt) w4[kt] = *(const f32x4*)(L + 640 + (16 * kt + 4 * q) * 4);
      __builtin_amdgcn_sched_barrier(0);
      const MOps& cur = ring[s & 1];
      uint4 pb0 = make_uint4(pack2bf(S[0][0], S[0][1]), pack2bf(S[0][2], S[0][3]), pack2bf(S[1][0], S[1][1]), pack2bf(S[1][2], S[1][3]));
      uint4 pb1 = make_uint4(pack2bf(S[2][0], S[2][1]), pack2bf(S[2][2], S[2][3]), pack2bf(S[3][0], S[3][1]), pack2bf(S[3][2], S[3][3]));
      f32x4 D = {0.f, 0.f, 0.f, 0.f};
      D = __builtin_amdgcn_mfma_f32_16x16x32_bf16(cur.a0, __builtin_bit_cast(bf16x8, pb0), D, 0, 0, 0);
      D = __builtin_amdgcn_mfma_f32_16x16x32_bf16(cur.a1, __builtin_bit_cast(bf16x8, pb1), D, 0, 0, 0);
      const float u = D[0], yprev = D[1];
      {
        const int pi = (s == 0) ? (d ? 0 : 15) : (d ? 16 - s : s - 1);
        yk[pi >> 2] = (q == (pi & 3)) ? yprev : yk[pi >> 2];
        if (s == 0 && c > 0) yflush(d ? T - 16 * c : 16 * (c - 1));
      }
      const uint32_t b3w = (cur.vv | (pack2bf(u, 0.f) << 16)) & qmask;
      const uint4 b3v = make_uint4(b3w, 0u, 0u, 0u);
      const bf16x8 B3 = __builtin_bit_cast(bf16x8, b3v);
#pragma unroll
      for (int kt = 0; kt < 4; ++kt) {
        const uint4 a3v = make_uint4(cur.kdb[kt] & qmask, 0u, 0u, 0u);
        const f32x4 C = S[kt] * w4[kt];
        S[kt] = __builtin_amdgcn_mfma_f32_16x16x32_bf16(__builtin_bit_cast(bf16x8, a3v), B3, C, 0, 0, 0);
      }
      rprev = L;
      __builtin_amdgcn_sched_barrier(0);
    }
    if (more) lstore((c + 1) & 1);
    __syncthreads();
  }
  {
    const char* aptr = (sel == 1) ? rprev + 128 + fragoff : lds + MS_ZERO;
    const bf16x8 a0 = *(const bf16x8*)aptr;
    const bf16x8 a1 = *(const bf16x8*)(aptr + 64);
    uint4 pb0 = make_uint4(pack2bf(S[0][0], S[0][1]), pack2bf(S[0][2], S[0][3]), pack2bf(S[1][0], S[1][1]), pack2bf(S[1][2], S[1][3]));
    uint4 pb1 = make_uint4(pack2bf(S[2][0], S[2][1]), pack2bf(S[2][2], S[2][3]), pack2bf(S[3][0], S[3][1]), pack2bf(S[3][2], S[3][3]));
    f32x4 D = {0.f, 0.f, 0.f, 0.f};
    D = __builtin_amdgcn_mfma_f32_16x16x32_bf16(a0, __builtin_bit_cast(bf16x8, pb0), D, 0, 0, 0);
    D = __builtin_amdgcn_mfma_f32_16x16x32_bf16(a1, __builtin_bit_cast(bf16x8, pb1), D, 0, 0, 0);
    const int pi = d ? 0 : 15;
    yk[pi >> 2] = (q == (pi & 3)) ? D[1] : yk[pi >> 2];
    yflush(d ? 0 : T - 16);
  }
  if (ctx) {
    float* so = p.out + (d ? 13631488 : 12582912) + ((size_t)(b * 8 + h) * 64 + row) * 64 + 4 * q;
#pragma unroll
    for (int kt = 0; kt < 4; ++kt) *(f32x4*)(so + 16 * kt) = S[kt];
  }
  __syncthreads();
}

DEVINL void scan_dispatch(const Params& p, int unit, char* lds) {
  int T, tokbase, b, h, d, qq;
  bool ctx;
  if (unit < 128) { qq = unit & 3; d = (unit >> 2) & 1; h = (unit >> 3) & 7; b = unit >> 6; T = 2048; tokbase = NCTX + b * 2048; ctx = false; }
  else { const int u = unit - 128; qq = u & 3; d = (u >> 2) & 1; h = (u >> 3) & 7; b = u >> 6; T = 256; tokbase = b * 256; ctx = true; }
  if (!ctx) __builtin_amdgcn_s_setprio(3);
  if (d) scan_unit<1>(p, T, tokbase, b, h, qq, ctx, lds);
  else scan_unit<0>(p, T, tokbase, b, h, qq, ctx, lds);
  if (!ctx) __builtin_amdgcn_s_setprio(0);
}

DEVINL void scan_dispatch_mfma(const Params& p, int unit, char* lds) {
  const bool ctx = unit >= 32;
  const int u = ctx ? unit - 32 : unit;
  const int d = u & 1, h = (u >> 1) & 7, b = u >> 4;
  const int T = ctx ? 256 : 2048;
  const int tokbase = ctx ? b * 256 : NCTX + b * 2048;
  if (d) scan_unit_mfma<1>(p, T, tokbase, b, h, ctx, lds);
  else scan_unit_mfma<0>(p, T, tokbase, b, h, ctx, lds);
}

DEVINL void post_item(const Params& p, int item, int lane) {
  const int r = lane & 15, q = lane >> 4;
  const u16* proj = (const u16*)(p.ws + OFF_PROJ);
  const u16* ops_s = (const u16*)(p.ws + OFF_OPS_S);
  const float* bonus = (const float*)(p.ws + OFF_BONUS);
  u16* mixed = (u16*)(p.ws + OFF_H);
  {
    const int tile = item >> 3, h = item & 7;
    const size_t m = (size_t)tile * 16 + r;
    float y[16];
    float sum = 0.f;
#pragma unroll
    for (int mt = 0; mt < 4; ++mt) {
      const int ch = h * 64 + 16 * mt + 4 * q;
      uint2 ya = *(const uint2*)(ybuf_ptr(p, 0, m) + ch);
      uint2 yb = *(const uint2*)(ybuf_ptr(p, 1, m) + ch);
      y[4 * mt + 0] = bflo(ya.x) + bflo(yb.x); y[4 * mt + 1] = bfhi(ya.x) + bfhi(yb.x); y[4 * mt + 2] = bflo(ya.y) + bflo(yb.y); y[4 * mt + 3] = bfhi(ya.y) + bfhi(yb.y);
      sum += y[4 * mt] + y[4 * mt + 1] + y[4 * mt + 2] + y[4 * mt + 3];
    }
    sum += __shfl_xor(sum, 16);
    sum += __shfl_xor(sum, 32);
    const float mean = sum * (1.f / 64.f);
    float var = 0.f;
#pragma unroll
    for (int i = 0; i < 16; ++i) { float dlt = y[i] - mean; var += dlt * dlt; }
    var += __shfl_xor(var, 16);
    var += __shfl_xor(var, 32);
    const float rstd = rsqrtf(var * (1.f / 64.f) + 64e-5f);
    const float bon = bonus[m * 8 + h];
#pragma unroll
    for (int mt = 0; mt < 4; ++mt) {
      const int c = 16 * mt + 4 * q, ch = h * 64 + c;
      float4 gg = *(const float4*)(p.gn_g + ch);
      float4 gb = *(const float4*)(p.gn_b + ch);
      uint2 vv = *(const uint2*)(ops_s + (m * 8 + h) * 192 + 128 + c);
      uint2 gr = *(const uint2*)(proj + m * NPROJ + 1664 + ch);
      float o0 = ((y[4 * mt + 0] - mean) * rstd * gg.x + gb.x + bon * bflo(vv.x)) * silu_f(bflo(gr.x));
      float o1 = ((y[4 * mt + 1] - mean) * rstd * gg.y + gb.y + bon * bfhi(vv.x)) * silu_f(bfhi(gr.x));
      float o2 = ((y[4 * mt + 2] - mean) * rstd * gg.z + gb.z + bon * bflo(vv.y)) * silu_f(bflo(gr.y));
      float o3 = ((y[4 * mt + 3] - mean) * rstd * gg.w + gb.w + bon * bfhi(vv.y)) * silu_f(bfhi(gr.y));
      *(uint2*)(mixed + kb_off(NTOK, (int)m, ch)) = pack4bf(o0, o1, o2, o3);
    }
  }
}
__device__ void phase5_latent(const Params& p) {
  const int tid = tid_opaque(), lane = tid & 63, w = tid >> 6;
  for (int it = blockIdx.x * 4 + w; it < 2048; it += gridDim.x * 4) post_item(p, 4096 + it, lane);
}

DEVINL void outproj_tile(const Params& p, int id, char* lds) {
  const u16* wot = (const u16*)(p.ws + OFF_WOT);
  const u16* mixed = (const u16*)(p.ws + OFF_H);
  const float* mod = (const float*)(p.ws + OFF_MOD);
  const float* rowtab = (const float*)(p.ws + OFF_ROWTAB);
  const float* coltab = (const float*)(p.ws + OFF_COLTAB);
  const float* xp = p.x_prompt; const float* xs = p.x_sample;
  float* out = p.out;
  {
    const int mg = id >> 6, rem = id & 63;
    const int nt = rem >> 3, mt = mg * 8 + (rem & 7);
    const int n0 = nt * 128, m0 = mt * 128;
    f32x4 acc[4][4];
    gemm_core(wot + (size_t)n0 * 64, (size_t)1024 * 128, mixed + (size_t)m0 * 64, (size_t)NTOK * 128, 16, lds, acc);
    const int tid = tid_opaque(), lane = tid & 63, w = tid >> 6, wp = w >> 1, wq = w & 1, fr = lane & 15, fq = lane >> 4;
    const bool lat = m0 >= NCTX;
    const int mi = lat ? 1 + ((m0 - NCTX) >> 11) : 0;
    const int nb = n0 + 64 * wp + 4 * fq;
    const int mb = m0 + 64 * wq + fr;
    float4 g4[4];
#pragma unroll
    for (int i = 0; i < 4; ++i) g4[i] = *(const float4*)(mod + mi * 3072 + 2048 + nb + 16 * i);
#pragma unroll
    for (int jh = 0; jh < 2; ++jh) {
      float4 x4[4][2], e4[4][2];
#pragma unroll
      for (int i = 0; i < 4; ++i)
#pragma unroll
        for (int jj = 0; jj < 2; ++jj) {
          const int m = mb + 16 * (2 * jh + jj), n = nb + 16 * i;
          if (!lat) {
            x4[i][jj] = *(const float4*)(xp + (size_t)m * 1024 + n);
            e4[i][jj] = make_float4(0.f, 0.f, 0.f, 0.f);
          } else {
            const int mp = m - NCTX, t = mp & 2047;
            x4[i][jj] = *(const float4*)(xs + (size_t)mp * 1024 + n);
            const float* e = n < 512 ? rowtab + (t >> 6) * 512 + n : coltab + (t & 63) * 512 + (n - 512);
            e4[i][jj] = *(const float4*)e;
          }
        }
#pragma unroll
      for (int i = 0; i < 4; ++i)
#pragma unroll
        for (int jj = 0; jj < 2; ++jj) {
          const int m = mb + 16 * (2 * jh + jj), n = nb + 16 * i;
          const f32x4 v = acc[i][2 * jh + jj];
          float4 o = make_float4(x4[i][jj].x + e4[i][jj].x + g4[i].x * v[0], x4[i][jj].y + e4[i][jj].y + g4[i].y * v[1],
                                 x4[i][jj].z + e4[i][jj].z + g4[i].z * v[2], x4[i][jj].w + e4[i][jj].w + g4[i].w * v[3]);
          *(float4*)(out + (size_t)m * 1024 + n) = o;
        }
    }
  }
}
__device__ void phase6_latent(const Params& p, char* lds) {
  constexpr int ID0 = 512, NTILES = 256;
  int first, step, last;
  if ((gridDim.x & 7) == 0) { const int per = NTILES / 8, x = blockIdx.x & 7; first = x * per + (blockIdx.x >> 3); step = gridDim.x >> 3; last = (x + 1) * per; }
  else { first = blockIdx.x; step = gridDim.x; last = NTILES; }
  for (int id = first; id < last; id += step) outproj_tile(p, ID0 + id, lds);
}

DEVINL void final_row(const Params& p, int m, int lane) {
  {
    float* rowp = p.out + (size_t)m * 1024;
    float4 v[4];
    float ss = 0.f;
#pragma unroll
    for (int i = 0; i < 4; ++i) {
      v[i] = *(const float4*)(rowp + lane * 4 + 256 * i);
      ss += v[i].x * v[i].x + v[i].y * v[i].y + v[i].z * v[i].z + v[i].w * v[i].w;
    }
    ss = wave_sum(ss);
    const float rstd = rsqrtf(ss * (1.f / 1024.f) + 1e-6f);
#pragma unroll
    for (int i = 0; i < 4; ++i) {
      float4 g4 = *(const float4*)(p.fng + lane * 4 + 256 * i);
      *(float4*)(rowp + lane * 4 + 256 * i) = make_float4(v[i].x * rstd * g4.x, v[i].y * rstd * g4.y, v[i].z * rstd * g4.z, v[i].w * rstd * g4.w);
    }
  }
}
__device__ void phase7_latent(const Params& p) {
  const int tid = tid_opaque(), lane = tid & 63, w = tid >> 6;
  for (int m = NCTX + blockIdx.x * 4 + w; m < NTOK; m += gridDim.x * 4) final_row(p, m, lane);
}

__device__ void phase4(const Params& p, char* lds) {
  const int tid = tid_opaque(), lane = tid & 63, w = tid >> 6;
  int* cnt = (int*)(p.ws + OFF_CNT);
  int role;
  if (gridDim.x == 512) {
    const int x = blockIdx.x & 7, i = blockIdx.x >> 3;
    const bool lat = i < 32 ? ((i & 3) == 0) : ((i & 3) == 2);
    role = lat ? x * 16 + (i >> 2) : (1 << 20);
  } else {
    role = next_unit(cnt + 1, lds);
  }
  if (role < 128) {
    scan_dispatch(p, role, lds);
  } else {
  XcdBarrier wb = xcd_barrier_post((unsigned*)(p.ws + OFF_BAR2), (volatile LAS unsigned*)(lds + 65536 + 32), gridDim.x - 128);
  int nst = 5;
  asm volatile("" : "+s"(nst));
  for (int stage = 0; stage < nst; ++stage) {
    const int nunits = stage == 0 ? 256 + 1024 : stage == 1 ? 512 + 128 : stage == 2 ? 1024 : 512;
    for (;;) {
      const int u = next_unit(cnt + 2 + stage, lds);
      if (u >= nunits) break;
      if (stage == 0) { if (u < 256) fnet_tile(p, false, u, lds); else prep_item(p, (u - 256) * 4 + w, lane); }
      else if (stage == 1) { if (u < 512) scan_dispatch_mfma(p, 32 + u, lds); else fnet_tile(p, true, u - 512, lds); }
      else if (stage == 2) post_item(p, u * 4 + w, lane);
      else if (stage == 3) outproj_tile(p, u, lds);
      else { const int m0 = u * 16 + w * 4; for (int i = 0; i < 4; ++i) final_row(p, m0 + i, lane); }
    }
    if (stage + 1 < nst) xcd_barrier(wb);
  }
  }
}

__global__ void __launch_bounds__(THREADS, 2) fwd_megakernel(Params p) {
  extern __shared__ __attribute__((aligned(16))) char lds[];
  if (p.use_cg) cg::this_grid().sync();
  if (threadIdx.x == 0) { *(uint4*)(lds + 65536 + 16) = make_uint4(0u, 0u, 0u, 0u); *(uint4*)(lds + 65536 + 32) = make_uint4(0u, 0u, 0u, 0u); }
  __syncthreads();
  XcdBarrier bar = xcd_barrier_post((unsigned*)(p.ws + OFF_BAR), (volatile LAS unsigned*)(lds + 65536 + 16), gridDim.x);
  phase0(p, lds);
  xcd_barrier(bar);
  phase1(p, lds);
  xcd_barrier(bar);
  phase2_all(p, lds);
  xcd_barrier(bar);
  phase3_latent(p);
  xcd_barrier(bar);
  phase4(p, lds);
  xcd_barrier(bar);
  phase5_latent(p);
  xcd_barrier(bar);
  phase6_latent(p, lds);
  xcd_barrier(bar);
  phase7_latent(p);
}

extern "C" void kernel_launch(void* const* d_in, const int* in_sizes, int n_in, void* d_out, int out_size, void* d_ws, size_t ws_size,
                              hipStream_t stream) {
  static int grid_blocks = 0;
  if (grid_blocks == 0) {
    if (n_in != 24 || ws_size < WS_NEED) {
      fprintf(stderr, "kernel_launch: need 24 inputs and >= %zu bytes of workspace (got %d, %zu)\n", (size_t)WS_NEED, n_in, ws_size);
      grid_blocks = -1;
      return;
    }
    int dev = 0, cus = 0, per_cu = 0;
    hipGetDevice(&dev);
    hipDeviceGetAttribute(&cus, hipDeviceAttributeMultiprocessorCount, dev);
    if (hipFuncSetAttribute((const void*)fwd_megakernel, hipFuncAttributeMaxDynamicSharedMemorySize, LDS_BYTES) != hipSuccess) {
      fprintf(stderr, "kernel_launch: hipFuncSetAttribute failed\n");
      grid_blocks = -1;
      return;
    }
    hipOccupancyMaxActiveBlocksPerMultiprocessor(&per_cu, (const void*)fwd_megakernel, THREADS, LDS_BYTES);
    if (per_cu < 1) { fprintf(stderr, "kernel_launch: occupancy query returned %d\n", per_cu); grid_blocks = -1; return; }
    if (per_cu > 2) per_cu = 2;
    grid_blocks = cus * per_cu;
  }
  if (grid_blocks < 0) return;
  hipMemsetAsync(d_ws, 0, ZERO_BYTES, stream);
  Params p{};
  const float* const* in = (const float* const*)d_in;
  p.x_prompt = in[0]; p.x_sample = in[1]; p.st_f = in[2]; p.st_b = in[3]; p.c = in[4]; p.c_ctx = in[5]; p.w_ada = in[6]; p.b_ada = in[7];
  p.norm_g = in[8]; p.w_in = in[9]; p.mu = in[10]; p.w0 = in[11]; p.w2 = in[12]; p.a0 = in[13]; p.a2 = in[14]; p.k_k = in[15]; p.k_a = in[16];
  p.r_k = in[17]; p.gn_g = in[18]; p.gn_b = in[19]; p.w_fnet = in[20]; p.b_fnet = in[21]; p.w_out = in[22]; p.fng = in[23];
  p.out = (float*)d_out;
  p.ws = (char*)d_ws;
  void* args[] = {&p};
  hipError_t e = hipLaunchCooperativeKernel((const void*)fwd_megakernel, dim3(grid_blocks), dim3(THREADS), args, LDS_BYTES, stream);
  if (e != hipSuccess) fprintf(stderr, "cooperative launch failed: %s (grid %d)\n", hipGetErrorString(e), grid_blocks);
}
```

```cpp
#include <hip/hip_runtime.h>
#include <hip/hip_cooperative_groups.h>
#include <cstdio>
#include <cstdint>
namespace cg = cooperative_groups;

#define DEVINL __device__ __forceinline__
typedef unsigned short u16;
typedef __attribute__((ext_vector_type(8))) short bf16x8;
typedef __attribute__((ext_vector_type(4))) float f32x4;
typedef __attribute__((ext_vector_type(2))) float f32x2;
typedef __attribute__((ext_vector_type(2))) __bf16 bf16x2v;

constexpr int NTOK = 12288;
constexpr int NCTX = 8192;
constexpr int NPROJ = 2688;
constexpr int NIN = 3712;
#ifndef LATENT_MFMA
#define LATENT_MFMA 0
#endif
constexpr int THREADS = 256;
constexpr int LDS_BYTES = 65536 + 256;

constexpr size_t OFF_MOD    = 0;
constexpr size_t OFF_CNT    = 36864;
constexpr size_t OFF_BAR    = 36864 + 256;
constexpr size_t OFF_BAR2   = OFF_BAR + 13824;
constexpr size_t ZERO_BYTES = 65536;
static_assert(OFF_BAR2 + 13824 <= ZERO_BYTES, "barrier words");
constexpr size_t OFF_WTIN   = 65536;
constexpr size_t OFF_WOT    = OFF_WTIN + 7602176;
constexpr size_t OFF_W2T    = OFF_WOT + 2097152;
constexpr size_t OFF_ROWTAB = OFF_W2T + 131072;
constexpr size_t OFF_COLTAB = OFF_ROWTAB + 65536;
constexpr size_t OFF_A256   = OFF_COLTAB + 131072;
constexpr size_t OFF_BONUS  = OFF_A256 + 262144;
constexpr size_t OFF_M      = OFF_BONUS + 393216;
constexpr size_t OFF_H      = 11534336;
constexpr size_t OFF_PROJ   = OFF_H + 25165824;
constexpr size_t OFF_OPS_S  = OFF_PROJ + 66060288;
constexpr size_t OFF_OPS_D  = OFF_OPS_S + 37748736;
constexpr size_t OFF_GTL    = OFF_OPS_D + 75497472;
constexpr size_t OFF_A2048  = OFF_GTL + 8388608;
constexpr size_t OFF_GTC    = OFF_A2048 + 16777216;
constexpr size_t OFF_YBUF   = OFF_GTC;
constexpr size_t WS_NEED    = OFF_YBUF + 16777216;
static_assert(OFF_M + 262144 <= OFF_H, "small region overflow");
static_assert(OFF_GTC + 16777216 <= WS_NEED, "alias");
static_assert(WS_NEED <= 268435456, "workspace");

struct Params {
  const float *x_prompt, *x_sample, *st_f, *st_b, *c, *c_ctx, *w_ada, *b_ada, *norm_g, *w_in, *mu, *w0, *w2, *a0, *a2,
      *k_k, *k_a, *r_k, *gn_g, *gn_b, *w_fnet, *b_fnet, *w_out, *fng;
  float* out;
  char* ws;
  int use_cg;
  int pad_;
};

DEVINL uint32_t pack2bf(float a, float b) {
  f32x2 v = {a, b};
  bf16x2v r = __builtin_convertvector(v, bf16x2v);
  return __builtin_bit_cast(uint32_t, r);
}
DEVINL u16 f2bf(float a) { return (u16)(pack2bf(a, 0.f) & 0xFFFFu); }
DEVINL uint2 pack4bf(float a, float b, float c, float d) { return make_uint2(pack2bf(a, b), pack2bf(c, d)); }
DEVINL float bflo(uint32_t w) { return __uint_as_float(w << 16); }
DEVINL float bfhi(uint32_t w) { return __uint_as_float(w & 0xFFFF0000u); }
DEVINL uint32_t pack2h(float a, float b) {
  _Float16 ha = (_Float16)a, hb = (_Float16)b;
  return (uint32_t)__builtin_bit_cast(u16, ha) | ((uint32_t)__builtin_bit_cast(u16, hb) << 16);
}
DEVINL float hlo(uint32_t w) { return (float)__builtin_bit_cast(_Float16, (u16)(w & 0xFFFFu)); }
DEVINL float hhi(uint32_t w) { return (float)__builtin_bit_cast(_Float16, (u16)(w >> 16)); }
DEVINL int tid_opaque() { int t = threadIdx.x; asm volatile("" : "+v"(t)); return t; }
DEVINL size_t kb_off(int R, int row, int k) { return ((size_t)(k >> 6) * R + row) * 64 + (k & 63); }
DEVINL float rcp_f(float x) { return __builtin_amdgcn_rcpf(x); }
DEVINL float sigmoid_f(float x) { return rcp_f(1.f + __expf(-x)); }
DEVINL float silu_f(float x) { return x * sigmoid_f(x); }
DEVINL float amul(float a, float b) { float r; asm("v_mul_f32 %0, %1, %2" : "=v"(r) : "v"(a), "v"(b)); return r; }
DEVINL float afma(float a, float b, float c) { float r; asm("v_fma_f32 %0, %1, %2, %3" : "=v"(r) : "v"(a), "v"(b), "v"(c)); return r; }
DEVINL float afnma(float a, float b, float c) { float r; asm("v_fma_f32 %0, -%1, %2, %3" : "=v"(r) : "v"(a), "v"(b), "v"(c)); return r; }
template <int CTRL>
DEVINL float dpp_f(float x) {
  return __int_as_float(__builtin_amdgcn_update_dpp(0, __float_as_int(x), CTRL, 0xF, 0xF, false));
}
DEVINL float allreduce16(float x) {
  x += dpp_f<0x128>(x);
  x += dpp_f<0x124>(x);
  x += dpp_f<0x122>(x);
  x += dpp_f<0x121>(x);
  return x;
}
DEVINL float wave_sum(float x) {
#pragma unroll
  for (int o = 32; o >= 1; o >>= 1) x += __shfl_xor(x, o);
  return x;
}


#define XB_TMO      128
#define XB_XCNT(j)  (256  + 64 * (j))
#define XB_XSUB(j)  (1280 + 64 * (j))
#define XB_XGEN(j)  (2304 + 64 * (j))
#define XB_TOP      3328
#define XB_TOPGEN   3392
#define XCD_BAR_WORDS 3456
#define XB_SPIN_CAP (1u << 22)
#define LAS __attribute__((address_space(3)))
DEVINL unsigned xb_ld(unsigned* p) { return __hip_atomic_load(p, __ATOMIC_RELAXED, __HIP_MEMORY_SCOPE_AGENT); }
DEVINL unsigned xb_add(unsigned* p, unsigned v) { return __hip_atomic_fetch_add(p, v, __ATOMIC_RELAXED, __HIP_MEMORY_SCOPE_AGENT); }
DEVINL unsigned xb_xcc_id() { return (unsigned)__builtin_amdgcn_s_getreg((3 << 11) | 20) & 0xFu; }
#define XB_SPIN(cond, bar) do { unsigned _sp = 0; while (cond) { __builtin_amdgcn_s_sleep(1); \
    if ((++_sp & 255u) == 0u) { if (xb_ld(&(bar)[XB_TMO])) break; if (_sp > XB_SPIN_CAP) { atomicAdd(&(bar)[XB_TMO], 1u); break; } } } } while (0)
struct XcdBarrier { unsigned* bar; unsigned x; volatile LAS unsigned* st; unsigned total; };
DEVINL XcdBarrier xcd_barrier_post(unsigned* bar, volatile LAS unsigned* st, unsigned total) {
  XcdBarrier b; b.bar = bar; b.x = xb_xcc_id(); b.st = st; b.total = total;
  if (threadIdx.x == 0) (void)xb_add(&bar[XB_XCNT(b.x)], 1u);
  return b;
}
DEVINL void xcd_barrier_complete(unsigned* bar, unsigned x, unsigned G, unsigned& nloc, unsigned& nx) {
  unsigned sum, cnt, mine, sp = 0u;
  for (;;) {
    sum = 0u; cnt = 0u; mine = 0u;
#pragma unroll
    for (unsigned j = 0; j < 16; ++j) { const unsigned c = xb_ld(&bar[XB_XCNT(j)]); sum += c; cnt += (c > 0u) ? 1u : 0u; mine = (j == x) ? c : mine; }
    if (sum == G) break;
    __builtin_amdgcn_s_sleep(1);
    if ((++sp & 255u) == 0u) { if (xb_ld(&bar[XB_TMO])) break; if (sp > XB_SPIN_CAP) { atomicAdd(&bar[XB_TMO], 1u); break; } }
  }
  nloc = mine > 0u ? mine : 1u; nx = cnt > 0u ? cnt : 1u;
}
DEVINL void xcd_barrier(const XcdBarrier& b) {
  asm volatile("s_waitcnt vmcnt(0)" ::: "memory");
  __syncthreads();
  if (threadIdx.x == 0) {
    unsigned* bar = b.bar;
    __builtin_amdgcn_s_waitcnt(0);
    unsigned nloc = b.st[0], nx = b.st[1];
    if (nloc == 0u) { xcd_barrier_complete(bar, b.x, b.total, nloc, nx); b.st[0] = nloc; b.st[1] = nx; }
    const unsigned old = xb_add(&bar[XB_XSUB(b.x)], 1u);
    const unsigned gen = old / nloc;
    if (old + 1u == (gen + 1u) * nloc) {
      __builtin_amdgcn_fence(__ATOMIC_RELEASE, "agent");
      asm volatile("s_waitcnt vmcnt(0)" ::: "memory");
      const unsigned og = xb_add(&bar[XB_TOP], 1u);
      const unsigned tg = og / nx;
      if (og + 1u == (tg + 1u) * nx) xb_add(&bar[XB_TOPGEN], 1u);
      else XB_SPIN(xb_ld(&bar[XB_TOPGEN]) == tg, bar);
      __builtin_amdgcn_fence(__ATOMIC_ACQUIRE, "agent");
      xb_add(&bar[XB_XGEN(b.x)], 1u);
      asm volatile("s_waitcnt vmcnt(0)" ::: "memory");
    } else {
      XB_SPIN(xb_ld(&bar[XB_XGEN(b.x)]) == gen, bar);
      __builtin_amdgcn_fence(__ATOMIC_ACQUIRE, "agent");
      asm volatile("s_waitcnt vmcnt(0)" ::: "memory");
    }
  }
  __syncthreads();
}

DEVINL u16* ybuf_ptr(const Params& p, int d, size_t m) {
  return m < (size_t)NCTX ? (u16*)(p.ws + OFF_YBUF) + ((size_t)d * NCTX + m) * 512
                          : (u16*)(p.out + 8388608) + ((size_t)d * 4096 + (m - NCTX)) * 512;
}
DEVINL void unit_done(int* ctr) {
  asm volatile("s_waitcnt vmcnt(0)" ::: "memory");
  __syncthreads();
  if (threadIdx.x == 0) {
    __builtin_amdgcn_fence(__ATOMIC_RELEASE, "agent");
    asm volatile("s_waitcnt vmcnt(0)" ::: "memory");
    (void)xb_add((unsigned*)ctr, 1u);
  }
}
DEVINL void wait_for(int* ctr, int target) {
  if (threadIdx.x == 0) {
    unsigned sp = 0;
    while ((int)xb_ld((unsigned*)ctr) < target) { __builtin_amdgcn_s_sleep(2); if (++sp > (1u << 24)) break; }
    __builtin_amdgcn_fence(__ATOMIC_ACQUIRE, "agent");
    asm volatile("s_waitcnt vmcnt(0)" ::: "memory");
  }
  __syncthreads();
}

#define GT_WAIT(n) asm volatile("s_waitcnt vmcnt(" #n ")" ::: "memory")
DEVINL void gemm_core(const u16* __restrict__ P, size_t ksp, const u16* __restrict__ Q, size_t ksq, int nk, char* lds, f32x4 (&acc)[4][4]) {
  const int tid = tid_opaque(), lane = tid & 63, w = tid >> 6, wp = w >> 1, wq = w & 1;
  const int fr = lane & 15, fq = lane >> 4;
#pragma unroll
  for (int i = 0; i < 4; ++i)
#pragma unroll
    for (int j = 0; j < 4; ++j) acc[i][j] = (f32x4){0.f, 0.f, 0.f, 0.f};
  const char* Pb = (const char*)P;
  const char* Qb = (const char*)Q;
  unsigned so[2];
#pragma unroll
  for (int k = 0; k < 2; ++k) {
    const int R = (2 * w + k) * 16 + (lane >> 2);
    const int c = (lane & 3) ^ ((R & 8) ? 3 : 0);
    so[k] = (unsigned)(R * 128 + c * 16);
  }
  const int nst = nk * 2;
  auto issue = [&](int st) {
    const size_t kb = (size_t)(st >> 1);
    const unsigned kh = (unsigned)(st & 1) * 64u;
    char* dstp = lds + (st & 3) * 16384 + (2 * w) * 1024;
    const char* ps = Pb + kb * ksp + kh;
    const char* qs = Qb + kb * ksq + kh;
    __builtin_amdgcn_global_load_lds((const unsigned*)(ps + so[0]), (unsigned*)(dstp), 16, 0, 0);
    __builtin_amdgcn_global_load_lds((const unsigned*)(ps + so[1]), (unsigned*)(dstp + 1024), 16, 0, 0);
    __builtin_amdgcn_global_load_lds((const unsigned*)(qs + so[0]), (unsigned*)(dstp + 8192), 16, 0, 0);
    __builtin_amdgcn_global_load_lds((const unsigned*)(qs + so[1]), (unsigned*)(dstp + 8192 + 1024), 16, 0, 0);
  };
  issue(0);
  issue(1);
  issue(2);
  const int sw = (fr & 8) ? 3 : 0;
  const int roff = fr * 64 + ((fq ^ sw) << 4);
  for (int st = 0; st < nst; ++st) {
    if (st + 2 < nst) GT_WAIT(8); else if (st + 1 < nst) GT_WAIT(4); else GT_WAIT(0);
    __builtin_amdgcn_s_barrier();
    if (st + 3 < nst) issue(st + 3);
    const char* bp = lds + (st & 3) * 16384;
    const char* bq = bp + 8192;
    bf16x8 a[4], b[4];
#pragma unroll
    for (int i = 0; i < 4; ++i) {
      a[i] = *(const bf16x8*)(bp + (64 * wp + 16 * i) * 64 + roff);
      b[i] = *(const bf16x8*)(bq + (64 * wq + 16 * i) * 64 + roff);
    }
#pragma unroll
    for (int i = 0; i < 4; ++i)
#pragma unroll
      for (int j = 0; j < 4; ++j) acc[i][j] = __builtin_amdgcn_mfma_f32_16x16x32_bf16(a[i], b[j], acc[i][j], 0, 0, 0);
  }
  __syncthreads();
}
template <class Epi>
DEVINL void gemm_tile(const u16* __restrict__ P, size_t ksp, const u16* __restrict__ Q, size_t ksq, int nk, char* lds, Epi epi) {
  f32x4 acc[4][4];
  gemm_core(P, ksp, Q, ksq, nk, lds, acc);
  const int tid = tid_opaque(), lane = tid & 63, w = tid >> 6, wp = w >> 1, wq = w & 1;
  const int fr = lane & 15, fq = lane >> 4;
#pragma unroll
  for (int i = 0; i < 4; ++i)
#pragma unroll
    for (int j = 0; j < 4; ++j) epi(64 * wp + 16 * i + 4 * fq, 64 * wq + 16 * j + fr, acc[i][j]);
}

DEVINL void transpose_unit(const float* __restrict__ src, int ld, int k0, int c0, u16* __restrict__ dst, int R, int n0, float* tile) {
  const int tid = tid_opaque();
#pragma unroll 4
  for (int i = 0; i < 16; ++i) {
    int kk = (tid >> 6) + 4 * i, nn = tid & 63;
    tile[kk * 65 + nn] = src[(size_t)(k0 + kk) * ld + c0 + nn];
  }
  __syncthreads();
#pragma unroll
  for (int i = 0; i < 2; ++i) {
    int nn = (tid >> 3) + 32 * i, kc = tid & 7;
    const float* t = tile + (kc * 8) * 65 + nn;
    uint4 o;
    o.x = pack2bf(t[0], t[65]);
    o.y = pack2bf(t[130], t[195]);
    o.z = pack2bf(t[260], t[325]);
    o.w = pack2bf(t[390], t[455]);
    *(uint4*)(dst + kb_off(R, n0 + nn, k0 + kc * 8)) = o;
  }
  __syncthreads();
}

__device__ void phase0(const Params& p, char* lds) {
  const int tid = tid_opaque();
  float* ldsf = (float*)lds;
  float* mod = (float*)(p.ws + OFF_MOD);
  constexpr int NU_M = 64, NU_MOD = 384, NU_TIN = 672, NU_TOUT = 256;
  constexpr int NU = NU_M + NU_MOD + NU_TIN + NU_TOUT;
  for (int u = blockIdx.x; u < NU; u += gridDim.x) {
    if (u < NU_M) {
      const int g = u >> 3, c8 = u & 7;
      float* tabc = ldsf; float* tabs = ldsf + 64;
      if (tid < 64) { float s, c; sincospif((float)tid * (1.f / 32.f), &s, &c); tabc[tid] = c; tabs[tid] = s; }
      __syncthreads();
      const int j2 = tid & 127, jj = j2 & 63;
      const float* tab = (j2 >> 6) ? tabs : tabc;
      const float* wf = p.w_fnet + (size_t)g * 4096 + jj;
      float* Mo = (float*)(p.ws + OFF_M) + (size_t)g * 8192;
      {
        const int cb = c8 * 8 + (tid >> 7);
        float s0 = 0.f, s1 = 0.f, s2 = 0.f, s3 = 0.f;
#pragma unroll 16
        for (int e = 0; e < 64; ++e) {
          const float wv = wf[e * 64];
          s0 += tab[(cb * e) & 63] * wv;
          s1 += tab[((cb + 2) * e) & 63] * wv;
          s2 += tab[((cb + 4) * e) & 63] * wv;
          s3 += tab[((cb + 6) * e) & 63] * wv;
        }
        Mo[cb * 128 + j2] = s0; Mo[(cb + 2) * 128 + j2] = s1; Mo[(cb + 4) * 128 + j2] = s2; Mo[(cb + 6) * 128 + j2] = s3;
      }
      __syncthreads();
    } else if (u < NU_M + NU_MOD) {
      const int v = u - NU_M;
      const int cb = v % 12, ks = v / 12;
      const int col = cb * 256 + tid;
      float a0 = 0.f, a1 = 0.f, a2 = 0.f;
      if (tid < 96) {
        const int kk = ks * 32 + (tid & 31), which = tid >> 5;
        const float cv = which == 0 ? p.c_ctx[kk] : p.c[(which - 1) * 1024 + kk];
        ldsf[tid] = silu_f(cv);
      }
      __syncthreads();
#pragma unroll 8
      for (int k = 0; k < 32; ++k) {
        float wv = p.w_ada[(size_t)(ks * 32 + k) * 3072 + col];
        a0 += ldsf[k] * wv;
        a1 += ldsf[32 + k] * wv;
        a2 += ldsf[64 + k] * wv;
      }
      __syncthreads();
      if (ks == 0) { float bb = p.b_ada[col]; a0 += bb; a1 += bb; a2 += bb; }
      unsafeAtomicAdd(&mod[col], a0);
      unsafeAtomicAdd(&mod[3072 + col], a1);
      unsafeAtomicAdd(&mod[6144 + col], a2);
    } else if (u < NU_M + NU_MOD + NU_TIN) {
      const int v = u - NU_M - NU_MOD;
      const int ktile = v & 15, ntile = v >> 4;
      const int n0 = ntile * 64;
      const int c0 = n0 < 2176 ? n0 : n0 + 512;
      transpose_unit(p.w_in, 3200, ktile * 64, c0, (u16*)(p.ws + OFF_WTIN), NIN, n0, ldsf);
    } else {
      const int v = u - NU_M - NU_MOD - NU_TIN;
      const int ktile = v & 15, ntile = v >> 4;
      transpose_unit(p.w_out, 1024, ktile * 64, ntile * 64, (u16*)(p.ws + OFF_WOT), 1024, ntile * 64, ldsf);
    }
  }
  const int gt = blockIdx.x * THREADS + tid, gn = gridDim.x * THREADS;
  {
    u16* w2t = (u16*)(p.ws + OFF_W2T);
    for (int i = gt; i < 65536; i += gn) {
      int j = i & 31, c = (i >> 5) & 511, combo = i >> 14;
      int d = combo >> 1;
      const float* src = (combo & 1) ? p.a2 : p.w2;
      w2t[i] = f2bf(src[((size_t)d * 32 + j) * 512 + c]);
    }
  }
  {
    float* rowtab = (float*)(p.ws + OFF_ROWTAB);
    float* coltab = (float*)(p.ws + OFF_COLTAB);
    for (int i = gt; i < 96 * 256; i += gn) {
      int f = i & 255, pos = i >> 8;
      float freq = expf(-9.210340371976184f * (float)f * (1.f / 256.f));
      float pv = pos < 32 ? (float)pos : (float)(pos - 32);
      float ang = pv * freq;
      float s = sinf(ang), c = cosf(ang);
      float* dst = pos < 32 ? rowtab + pos * 512 : coltab + (pos - 32) * 512;
      dst[f] = s; dst[256 + f] = c;
    }
  }
  {
    u16* a256 = (u16*)(p.ws + OFF_A256);
    for (int i = gt; i < 256 * 256; i += gn) {
      int k = i & 255, tp = i >> 8;
      int m = (tp * k) & 255;
      float s, c; sincospif((float)m * (1.f / 128.f), &s, &c);
      a256[kb_off(256, tp, k)] = f2bf(c);
      a256[kb_off(256, tp, 256 + k)] = f2bf(-s);
    }
    u16* a2048 = (u16*)(p.ws + OFF_A2048);
    __syncthreads();
    float* ctab = ldsf;
    for (int m = tid; m < 2048; m += THREADS) { float sn, cs; sincospif((float)m * (1.f / 1024.f), &sn, &cs); ctab[m] = cs; }
    __syncthreads();
    for (int i = gt; i < 2048 * 2048; i += gn) {
      int k = i & 2047, tp = i >> 11;
      int m = (tp * k) & 2047;
      a2048[kb_off(2048, tp, k)] = f2bf(ctab[m]);
      a2048[kb_off(2048, tp, 2048 + k)] = f2bf(-ctab[(m - 512) & 2047]);
    }
  }
}

__device__ void phase1(const Params& p, char* lds) {
  const int tid = tid_opaque(), lane = tid & 63, w = tid >> 6;
  float* ldsf = (float*)lds;
  const float* mod = (const float*)(p.ws + OFF_MOD);
  const float* rowtab = (const float*)(p.ws + OFF_ROWTAB);
  const float* coltab = (const float*)(p.ws + OFF_COLTAB);
  u16* hbuf = (u16*)(p.ws + OFF_H);
  constexpr int NU_FOLD = 512, NU_ROWS = NTOK / 8;
  for (int u = blockIdx.x; u < NU_FOLD + NU_ROWS; u += gridDim.x) {
    if (u < NU_FOLD) {
      const int g = u >> 6, k0 = ((u >> 2) & 15) * 64, jq = (u & 3) * 32;
      float* Ml = ldsf;
      float* Wl = ldsf + 2048;
      const float* Mg = (const float*)(p.ws + OFF_M) + (size_t)g * 8192 + jq;
      for (int i = tid; i < 512; i += THREADS) ((float4*)Ml)[i] = *(const float4*)(Mg + (i >> 3) * 128 + (i & 7) * 4);
#pragma unroll 4
      for (int i = 0; i < 16; ++i) {
        int kk = (tid >> 6) + 4 * i, cc = tid & 63;
        Wl[kk * 65 + cc] = p.w_in[(size_t)(k0 + kk) * 3200 + 2176 + g * 64 + cc];
      }
      __syncthreads();
      u16* dst = (u16*)(p.ws + OFF_WTIN);
      for (int grp = 0; grp < 2; ++grp) {
        const int jl = w * 8 + grp * 4;
        float s0 = 0.f, s1 = 0.f, s2 = 0.f, s3 = 0.f;
#pragma unroll 8
        for (int cc = 0; cc < 64; ++cc) {
          float wl = Wl[lane * 65 + cc];
          float4 m4 = *(const float4*)(Ml + cc * 32 + jl);
          s0 += wl * m4.x; s1 += wl * m4.y; s2 += wl * m4.z; s3 += wl * m4.w;
        }
        size_t o = kb_off(NIN, 2688 + g * 128 + jq + jl, k0 + lane);
        dst[o] = f2bf(s0); dst[o + 64] = f2bf(s1); dst[o + 128] = f2bf(s2); dst[o + 192] = f2bf(s3);
      }
      __syncthreads();
    } else {
      const int mb = (u - NU_FOLD) * 8 + w * 2;
      const bool lat = mb >= NCTX;
      const int mi = lat ? 1 + ((mb - NCTX) >> 11) : 0;
      float4 v[2][4];
      float ss[2] = {0.f, 0.f};
#pragma unroll
      for (int rr = 0; rr < 2; ++rr) {
        const int m = mb + rr, mp = m - NCTX, t = mp & 2047;
        const float* xr = lat ? p.x_sample + (size_t)mp * 1024 : p.x_prompt + (size_t)m * 1024;
#pragma unroll
        for (int i = 0; i < 4; ++i) {
          const int col = lane * 4 + 256 * i;
          v[rr][i] = *(const float4*)(xr + col);
          if (lat) {
            const float* e = col < 512 ? rowtab + (t >> 6) * 512 + col : coltab + (t & 63) * 512 + (col - 512);
            float4 e4 = *(const float4*)e;
            v[rr][i].x += e4.x; v[rr][i].y += e4.y; v[rr][i].z += e4.z; v[rr][i].w += e4.w;
          }
          ss[rr] += v[rr][i].x * v[rr][i].x + v[rr][i].y * v[rr][i].y + v[rr][i].z * v[rr][i].z + v[rr][i].w * v[rr][i].w;
        }
      }
      ss[0] = wave_sum(ss[0]);
      ss[1] = wave_sum(ss[1]);
      const float rstd0 = rsqrtf(ss[0] * (1.f / 1024.f) + 1e-6f), rstd1 = rsqrtf(ss[1] * (1.f / 1024.f) + 1e-6f);
#pragma unroll
      for (int i = 0; i < 4; ++i) {
        const int col = lane * 4 + 256 * i;
        float4 g4 = *(const float4*)(p.norm_g + col);
        float4 sh = *(const float4*)(mod + mi * 3072 + col);
        float4 sc = *(const float4*)(mod + mi * 3072 + 1024 + col);
        const float gx = g4.x * (1.f + sc.x), gy = g4.y * (1.f + sc.y), gz = g4.z * (1.f + sc.z), gw = g4.w * (1.f + sc.w);
#pragma unroll
        for (int rr = 0; rr < 2; ++rr) {
          const float rstd = rr ? rstd1 : rstd0;
          float h0 = v[rr][i].x * rstd * gx + sh.x;
          float h1 = v[rr][i].y * rstd * gy + sh.y;
          float h2 = v[rr][i].z * rstd * gz + sh.z;
          float h3 = v[rr][i].w * rstd * gw + sh.w;
          *(uint2*)(hbuf + kb_off(NTOK, mb + rr, col)) = pack4bf(h0, h1, h2, h3);
        }
      }
    }
  }
}

DEVINL void inproj_tile(const Params& p, int id, char* lds) {
  const u16* hbuf = (const u16*)(p.ws + OFF_H);
  const u16* wt = (const u16*)(p.ws + OFF_WTIN);
  u16* proj = (u16*)(p.ws + OFF_PROJ);
  u16* gtc = (u16*)(p.ws + OFF_GTC);
  u16* gtl = (u16*)(p.ws + OFF_GTL);
  constexpr int NT = 29;
  constexpr size_t KS_W = (size_t)NIN * 128, KS_H = (size_t)NTOK * 128;
  const int mg = id / (NT * 8), rem = id % (NT * 8);
  const int nt = rem >> 3, mt = mg * 8 + (rem & 7);
  const int m0 = mt * 128, n0 = nt * 128;
  if (nt < 21) {
    f32x4 acc[4][4];
    gemm_core(wt + (size_t)n0 * 64, KS_W, hbuf + (size_t)m0 * 64, KS_H, 16, lds, acc);
    const int tid = tid_opaque(), lane = tid & 63, w = tid >> 6, wp = w >> 1, wq = w & 1, fr = lane & 15, fq = lane >> 4;
    constexpr int CST = 272;
#pragma unroll
    for (int i = 0; i < 4; ++i)
#pragma unroll
      for (int j = 0; j < 4; ++j) {
        const int ql = 64 * wq + 16 * j + fr, pl = 64 * wp + 16 * i + 4 * fq;
        *(uint2*)(lds + ql * CST + pl * 2) = pack4bf(acc[i][j][0], acc[i][j][1], acc[i][j][2], acc[i][j][3]);
      }
    __syncthreads();
#pragma unroll
    for (int k = 0; k < 8; ++k) {
      const int row = (tid >> 4) + 16 * k, c16 = tid & 15;
      const uint4 v = *(const uint4*)(lds + row * CST + c16 * 16);
      *(uint4*)(proj + (size_t)(m0 + row) * NPROJ + n0 + c16 * 8) = v;
    }
    __syncthreads();
  } else {
    const int g = nt - 21;
    f32x4 acc[4][4];
    gemm_core(hbuf + (size_t)m0 * 64, KS_H, wt + (size_t)n0 * 64, KS_W, 16, lds, acc);
    const int tid = tid_opaque(), lane = tid & 63, w = tid >> 6, wp = w >> 1, wq = w & 1, fr = lane & 15, fq = lane >> 4;
    constexpr int CST = 272;
#pragma unroll
    for (int i = 0; i < 4; ++i)
#pragma unroll
      for (int j = 0; j < 4; ++j) {
        const int ql = 64 * wq + 16 * j + fr, pl = 64 * wp + 16 * i + 4 * fq;
        *(uint2*)(lds + ql * CST + pl * 2) = pack4bf(acc[i][j][0], acc[i][j][1], acc[i][j][2], acc[i][j][3]);
      }
    __syncthreads();
    const bool isctx = m0 < NCTX;
    const int bb = isctx ? (m0 >> 8) : ((m0 - NCTX) >> 11);
    const int tb = isctx ? (m0 & 255) : ((m0 - NCTX) & 2047);
#pragma unroll
    for (int k = 0; k < 8; ++k) {
      const int row = (tid >> 4) + 16 * k, c16 = tid & 15;
      const uint4 v = *(const uint4*)(lds + row * CST + c16 * 16);
      const int part = row >> 6, cp = row & 63, t = tb + c16 * 8;
      u16* dst = isctx ? gtc + kb_off(16384, (bb * 8 + g) * 64 + cp, part * 256 + t)
                       : gtl + kb_off(1024, (bb * 8 + g) * 64 + cp, part * 2048 + t);
      *(uint4*)dst = v;
    }
    __syncthreads();
  }
}
__device__ void phase2_all(const Params& p, char* lds) {
  constexpr int NTILES = 29 * 96;
  int first, step, last;
  if ((gridDim.x & 7) == 0) { const int per = NTILES / 8, x = blockIdx.x & 7; first = x * per + (blockIdx.x >> 3); step = gridDim.x >> 3; last = (x + 1) * per; }
  else { first = blockIdx.x; step = gridDim.x; last = NTILES; }
  for (int id = first; id < last; id += step) inproj_tile(p, id, lds);
}

DEVINL void mix4(const u16* prow, bool hasPrev, bool hasNext, const float* mu, int col, float* o) {
  uint2 c = *(const uint2*)(prow + col);
  uint2 pv = make_uint2(0u, 0u), nx = make_uint2(0u, 0u);
  if (hasPrev) pv = *(const uint2*)(prow - NPROJ + col);
  if (hasNext) nx = *(const uint2*)(prow + NPROJ + col);
  float4 m4 = *(const float4*)(mu + col);
  float c0 = bflo(c.x), c1 = bfhi(c.x), c2 = bflo(c.y), c3 = bfhi(c.y);
  o[0] = c0 + m4.x * (0.5f * (bflo(pv.x) + bflo(nx.x)) - c0);
  o[1] = c1 + m4.y * (0.5f * (bfhi(pv.x) + bfhi(nx.x)) - c1);
  o[2] = c2 + m4.z * (0.5f * (bflo(pv.y) + bflo(nx.y)) - c2);
  o[3] = c3 + m4.w * (0.5f * (bfhi(pv.y) + bfhi(nx.y)) - c3);
}
DEVINL void mix8(const u16* prow, bool hasPrev, bool hasNext, const float* mu, int col, float* o) {
  mix4(prow, hasPrev, hasNext, mu, col, o);
  mix4(prow, hasPrev, hasNext, mu, col + 4, o + 4);
}
DEVINL float tanh_f(float x) {
  float e = __expf(2.f * x);
  return 1.f - 2.f * rcp_f(e + 1.f);
}

DEVINL void prep_item(const Params& p, int item, int lane) {
  const int tile = item >> 3, h = item & 7;
  const int r = lane & 15, q = lane >> 4;
  const int m = tile * 16 + r;
  int T, t;
  if (m < NCTX) { T = 256; t = m & 255; } else { T = 2048; t = (m - NCTX) & 2047; }
  const bool hasPrev = t > 0, hasNext = t < T - 1;
  const u16* prow = (const u16*)(p.ws + OFF_PROJ) + (size_t)m * NPROJ;
  const u16* w2t = (const u16*)(p.ws + OFF_W2T);
  u16* ops_s = (u16*)(p.ws + OFF_OPS_S) + ((size_t)m * 8 + h) * 192;
  u16* ops_d = (u16*)(p.ws + OFF_OPS_D) + ((size_t)m * 8 + h) * 384;

  bf16x8 xw[2], xa[2];
#pragma unroll
  for (int d = 0; d < 2; ++d) {
    float t8[8];
    mix8(prow, hasPrev, hasNext, p.mu, 1536 + d * 32 + 8 * q, t8);
#pragma unroll
    for (int e = 0; e < 8; ++e) t8[e] = tanh_f(t8[e]);
    uint4 pk = make_uint4(pack2bf(t8[0], t8[1]), pack2bf(t8[2], t8[3]), pack2bf(t8[4], t8[5]), pack2bf(t8[6], t8[7]));
    xw[d] = __builtin_bit_cast(bf16x8, pk);
    mix8(prow, hasPrev, hasNext, p.mu, 1600 + d * 32 + 8 * q, t8);
    pk = make_uint4(pack2bf(t8[0], t8[1]), pack2bf(t8[2], t8[3]), pack2bf(t8[4], t8[5]), pack2bf(t8[6], t8[7]));
    xa[d] = __builtin_bit_cast(bf16x8, pk);
  }
  float nsq = 0.f;
#pragma unroll 4
  for (int mt = 0; mt < 4; ++mt) {
    const int ch = h * 64 + 16 * mt + 4 * q;
    float kp[4];
    mix4(prow, hasPrev, hasNext, p.mu, 512 + ch, kp);
    float4 kk4 = *(const float4*)(p.k_k + ch);
    float a0 = kp[0] * kk4.x, a1 = kp[1] * kk4.y, a2 = kp[2] * kk4.z, a3 = kp[3] * kk4.w;
    nsq += a0 * a0 + a1 * a1 + a2 * a2 + a3 * a3;
  }
  nsq += __shfl_xor(nsq, 16);
  nsq += __shfl_xor(nsq, 32);
  const float inv = 1.f / fmaxf(sqrtf(nsq), 1e-12f);
  float bon = 0.f;
#pragma unroll 1
  for (int mt = 0; mt < 4; ++mt) {
    const int c = 16 * mt + 4 * q;
    const int ch = h * 64 + c;
    float rp[4], vp[4], kk[4], kp[4];
    mix4(prow, hasPrev, hasNext, p.mu, 512 + ch, kp);
    mix4(prow, hasPrev, hasNext, p.mu, ch, rp);
    mix4(prow, hasPrev, hasNext, p.mu, 1024 + ch, vp);
    {
      float4 kk4 = *(const float4*)(p.k_k + ch);
      kk[0] = kp[0] * kk4.x * inv; kk[1] = kp[1] * kk4.y * inv; kk[2] = kp[2] * kk4.z * inv; kk[3] = kp[3] * kk4.w * inv;
    }
    *(uint2*)(ops_s + c) = pack4bf(kk[0], kk[1], kk[2], kk[3]);
    *(uint2*)(ops_s + 64 + c) = pack4bf(rp[0], rp[1], rp[2], rp[3]);
    *(uint2*)(ops_s + 128 + c) = pack4bf(vp[0], vp[1], vp[2], vp[3]);
    const float4 ka4 = *(const float4*)(p.k_a + ch);
    const float4 rk4 = *(const float4*)(p.r_k + ch);
    const float kav[4] = {ka4.x, ka4.y, ka4.z, ka4.w};
    const float rkv[4] = {rk4.x, rk4.y, rk4.z, rk4.w};
#pragma unroll
    for (int d = 0; d < 2; ++d) {
      bf16x8 aw = *(const bf16x8*)(w2t + ((size_t)((d * 2 + 0) * 512 + h * 64 + 16 * mt + r)) * 32 + 8 * q);
      bf16x8 aa = *(const bf16x8*)(w2t + ((size_t)((d * 2 + 1) * 512 + h * 64 + 16 * mt + r)) * 32 + 8 * q);
      f32x4 z0 = {0.f, 0.f, 0.f, 0.f};
      f32x4 zw = __builtin_amdgcn_mfma_f32_16x16x32_bf16(aw, xw[d], z0, 0, 0, 0);
      f32x4 za = __builtin_amdgcn_mfma_f32_16x16x32_bf16(aa, xa[d], z0, 0, 0, 0);
      const float4 w04 = *(const float4*)(p.w0 + d * 512 + ch);
      const float4 a04 = *(const float4*)(p.a0 + d * 512 + ch);
      const float w0v[4] = {w04.x, w04.y, w04.z, w04.w};
      const float a0v[4] = {a04.x, a04.y, a04.z, a04.w};
      float wd[4], kd[4], bb[4];
#pragma unroll
      for (int i = 0; i < 4; ++i) {
        float sg = sigmoid_f(zw[i] + w0v[i]);
        wd[i] = __expf(-0.6065306597126334f * sg);
        float av = sigmoid_f(za[i] + a0v[i]);
        kd[i] = kp[i] * (1.f + (av - 1.f) * kav[i]);
        bb[i] = kk[i] * av;
        bon += rp[i] * kd[i] * rkv[i];
      }
      u16* pd = ops_d + d * 192;
      *(uint2*)(pd + c) = make_uint2(pack2h(wd[0], wd[1]), pack2h(wd[2], wd[3]));
      *(uint2*)(pd + 64 + c) = pack4bf(kd[0], kd[1], kd[2], kd[3]);
      *(uint2*)(pd + 128 + c) = pack4bf(bb[0], bb[1], bb[2], bb[3]);
    }
  }
  bon += __shfl_xor(bon, 16);
  bon += __shfl_xor(bon, 32);
  if (q == 0) ((float*)(p.ws + OFF_BONUS))[(size_t)m * 8 + h] = bon;
}

DEVINL void fnet_tile(const Params& p, bool latn, int u, char* lds) {
  const int tid = tid_opaque(), lane = tid & 63, w = tid >> 6;
  const u16* proj = (const u16*)(p.ws + OFF_PROJ);
  u16* mixed = (u16*)(p.ws + OFF_H);
  {
      int p0, q0; size_t mbase; float scale;
      f32x4 acc[4][4];
      if (latn) {
        p0 = (u & 7) * 128; q0 = (u >> 3) * 128;
        scale = 0.002762135864009951f;
        mbase = NCTX + (size_t)(p0 >> 9) * 2048 + q0;
        gemm_core((const u16*)(p.ws + OFF_GTL) + (size_t)p0 * 64, (size_t)1024 * 128, (const u16*)(p.ws + OFF_A2048) + (size_t)q0 * 64, (size_t)2048 * 128, 64, lds, acc);
      } else {
        const int v0 = u;
        p0 = (v0 >> 1) * 128; q0 = (v0 & 1) * 128;
        scale = 0.0078125f;
        mbase = (size_t)(p0 >> 9) * 256 + q0;
        gemm_core((const u16*)(p.ws + OFF_GTC) + (size_t)p0 * 64, (size_t)16384 * 128, (const u16*)(p.ws + OFF_A256) + (size_t)q0 * 64, (size_t)256 * 128, 8, lds, acc);
      }
      const int wp = w >> 1, wq = w & 1, fr = lane & 15, fq = lane >> 4;
      const int gc0 = (p0 & 511) + 64 * wp + 4 * fq;
      const size_t m0 = mbase + 64 * wq + fr;
      uint2 gf[4][4];
      float4 b4[4];
#pragma unroll
      for (int i = 0; i < 4; ++i) {
        b4[i] = *(const float4*)(p.b_fnet + gc0 + 16 * i);
#pragma unroll
        for (int j = 0; j < 4; ++j) gf[i][j] = *(const uint2*)(proj + (m0 + 16 * j) * NPROJ + 2176 + gc0 + 16 * i);
      }
#pragma unroll
      for (int i = 0; i < 4; ++i)
#pragma unroll
        for (int j = 0; j < 4; ++j) {
          const f32x4 v = acc[i][j];
          float o0 = (v[0] * scale + b4[i].x) * silu_f(bflo(gf[i][j].x));
          float o1 = (v[1] * scale + b4[i].y) * silu_f(bfhi(gf[i][j].x));
          float o2 = (v[2] * scale + b4[i].z) * silu_f(bflo(gf[i][j].y));
          float o3 = (v[3] * scale + b4[i].w) * silu_f(bfhi(gf[i][j].y));
          *(uint2*)(mixed + kb_off(NTOK, (int)(m0 + 16 * j), 512 + gc0 + 16 * i)) = pack4bf(o0, o1, o2, o3);
        }
  }
}

DEVINL int next_unit(int* counter, char* lds) {
  volatile int* slot = (volatile int*)(lds + 65536);
  __syncthreads();
  if (threadIdx.x == 0) *slot = atomicAdd(counter, 1);
  __syncthreads();
  return *slot;
}

__device__ void phase3_latent(const Params& p) {
  const int tid = tid_opaque(), lane = tid & 63, w = tid >> 6;
  for (int it = blockIdx.x * 4 + w; it < 2048; it += gridDim.x * 4) prep_item(p, 4096 + it, lane);
}

struct StepOps { f32x4 kk, r, w, kd, b; float v; };
DEVINL StepOps load_ops(const float* L, int j, int row) {
  StepOps o;
  o.kk = *(const f32x4*)(L + 4 * j);
  o.r = *(const f32x4*)(L + 64 + 4 * j);
  o.v = L[128 + row];
  o.w = *(const f32x4*)(L + 192 + 4 * j);
  o.kd = *(const f32x4*)(L + 256 + 4 * j);
  o.b = *(const f32x4*)(L + 320 + 4 * j);
  return o;
}
template <int DIR>
DEVINL void scan_unit(const Params& p, int T, int tokbase, int b, int h, int qq, bool ctx, char* lds) {
  constexpr int d = DIR;
  const int tid = tid_opaque(), lane = tid & 63, w = tid >> 6;
  const int g = lane >> 4, j = lane & 15;
  const int row = qq * 16 + w * 4 + g;
  float S0 = 0.f, S1 = 0.f, S2 = 0.f, S3 = 0.f;
  if (!ctx) {
    const float* s0 = (d ? p.st_b : p.st_f) + ((size_t)(b * 8 + h) * 64 + row) * 64 + 4 * j;
    f32x4 s4 = *(const f32x4*)s0;
    S0 = s4[0]; S1 = s4[1]; S2 = s4[2]; S3 = s4[3];
  }
  const u16* ops_s = (const u16*)(p.ws + OFF_OPS_S);
  const u16* ops_d = (const u16*)(p.ws + OFF_OPS_D);
  float* ldsf = (float*)lds;
  u16* yout = ybuf_ptr(p, d, (size_t)tokbase) + h * 64 + row;
  const int nchunks = T >> 4;
  int ps[3], pw[3];
#pragma unroll
  for (int i = 0; i < 3; ++i) { int pi = tid + 256 * i; ps[i] = pi / 48; pw[i] = pi % 48; }
  uint4 rg0[3], rg1[3], rg2[3], rg3[3];
  const char* gp[3];
  int gst[3];
#pragma unroll
  for (int i = 0; i < 3; ++i) {
    const size_t tok = (size_t)(tokbase + (d ? T - 16 : 0) + ps[i]);
    const u16* src = pw[i] < 24 ? ops_s + (tok * 8 + h) * 192 + pw[i] * 8
                                : ops_d + ((tok * 8 + h) * 2 + d) * 192 + (pw[i] - 24) * 8;
    gp[i] = (const char*)src;
    gst[i] = (pw[i] < 24 ? 16 * 8 * 192 * 2 : 16 * 8 * 2 * 192 * 2) * (d ? -1 : 1);
  }
  auto gload = [&](int c, uint4 (&r)[3]) __attribute__((always_inline)) {
    (void)c;
#pragma unroll
    for (int i = 0; i < 3; ++i) { r[i] = *(const uint4*)gp[i]; gp[i] += gst[i]; }
  };
  auto lstore = [&](int buf, const uint4 (&r)[3]) __attribute__((always_inline)) {
#pragma unroll
    for (int i = 0; i < 3; ++i) {
      float* dst = ldsf + buf * 6144 + ps[i] * 384 + pw[i] * 8;
      float4 a, bq;
      if (pw[i] >= 24 && pw[i] < 32) {
        a = make_float4(hlo(r[i].x), hhi(r[i].x), hlo(r[i].y), hhi(r[i].y));
        bq = make_float4(hlo(r[i].z), hhi(r[i].z), hlo(r[i].w), hhi(r[i].w));
      } else {
        a = make_float4(bflo(r[i].x), bfhi(r[i].x), bflo(r[i].y), bfhi(r[i].y));
        bq = make_float4(bflo(r[i].z), bfhi(r[i].z), bflo(r[i].w), bfhi(r[i].w));
      }
      *(float4*)dst = a;
      *(float4*)(dst + 4) = bq;
    }
  };
  gload(0, rg0);
  gload(1, rg1);
  gload(2, rg2);
  lstore(0, rg0);
  __syncthreads();
  auto chunk = [&](const int c, const int cc, uint4 (&ldset)[3], const uint4 (&stset)[3]) __attribute__((always_inline)) {
    {
      if (c + 3 < nchunks) gload(c + 3, ldset);
      const float* L0 = ldsf + (cc & 1) * 6144;
      const int t0 = d ? T - 16 * (c + 1) : 16 * c;
      StepOps ring[3];
      ring[0] = load_ops(L0 + (d ? 15 : 0) * 384, j, row);
      ring[1] = load_ops(L0 + (d ? 14 : 1) * 384, j, row);
      float ykeep = 0.f;
#pragma unroll
      for (int s = 0; s < 16; ++s) {
        const int li = d ? 15 - s : s;
        if (s + 2 < 16) ring[(s + 2) % 3] = load_ops(L0 + (d ? 13 - s : s + 2) * 384, j, row);
        __builtin_amdgcn_sched_barrier(0);
        const StepOps& cur = ring[s % 3];
        float ua = amul(S0, cur.kk[0]);
        float ub = amul(S2, cur.kk[2]);
        ua = afma(S1, cur.kk[1], ua);
        ub = afma(S3, cur.kk[3], ub);
        const float u = allreduce16(ua + ub);
        float t0 = amul(cur.v, cur.kd[0]), t1 = amul(cur.v, cur.kd[1]), t2 = amul(cur.v, cur.kd[2]), t3 = amul(cur.v, cur.kd[3]);
        t0 = afnma(u, cur.b[0], t0); t1 = afnma(u, cur.b[1], t1); t2 = afnma(u, cur.b[2], t2); t3 = afnma(u, cur.b[3], t3);
        S0 = afma(S0, cur.w[0], t0); S1 = afma(S1, cur.w[1], t1); S2 = afma(S2, cur.w[2], t2); S3 = afma(S3, cur.w[3], t3);
        float ya = amul(S0, cur.r[0]);
        float yb = amul(S2, cur.r[2]);
        ya = afma(S1, cur.r[1], ya);
        yb = afma(S3, cur.r[3], yb);
        const float y = allreduce16(ya + yb);
        ykeep = (j == li) ? y : ykeep;
        __builtin_amdgcn_sched_barrier(0);
      }
      yout[(size_t)(t0 + j) * 512] = f2bf(ykeep);
      if (c + 1 < nchunks) lstore((cc + 1) & 1, stset);
      __syncthreads();
    }
  };
  for (int c4 = 0; c4 < nchunks; c4 += 4) {
    chunk(c4 + 0, 0, rg3, rg1);
    chunk(c4 + 1, 1, rg0, rg2);
    chunk(c4 + 2, 2, rg1, rg3);
    chunk(c4 + 3, 3, rg2, rg0);
  }
  if (ctx) {
    float* so = p.out + (d ? 13631488 : 12582912) + ((size_t)(b * 8 + h) * 64 + row) * 64 + 4 * j;
    *(f32x4*)so = (f32x4){S0, S1, S2, S3};
  }
}
constexpr int MS_STEP = 896, MS_BUF = 16 * MS_STEP, MS_ZERO = 2 * MS_BUF;
template <int DIR>
DEVINL void scan_unit_mfma(const Params& p, int T, int tokbase, int b, int h, bool ctx, char* lds) {
  constexpr int d = DIR;
  const int tid = tid_opaque(), lane = tid & 63, wv = tid >> 6;
  const int vr = lane & 15, q = lane >> 4;
  const int row = wv * 16 + vr;
  f32x4 S[4];
#pragma unroll
  for (int kt = 0; kt < 4; ++kt) S[kt] = (f32x4){0.f, 0.f, 0.f, 0.f};
  if (!ctx) {
    const float* s0 = (d ? p.st_b : p.st_f) + ((size_t)(b * 8 + h) * 64 + row) * 64 + 4 * q;
#pragma unroll
    for (int kt = 0; kt < 4; ++kt) S[kt] = *(const f32x4*)(s0 + 16 * kt);
  }
  const u16* ops_s = (const u16*)(p.ws + OFF_OPS_S);
  const u16* ops_d = (const u16*)(p.ws + OFF_OPS_D);
  u16* ybase = ybuf_ptr(p, d, (size_t)tokbase) + h * 64 + row;
  const int nchunks = T >> 4;
  if (tid < 16) *(uint4*)(lds + MS_ZERO + tid * 16) = make_uint4(0u, 0u, 0u, 0u);
  int fs[3], fw[3];
#pragma unroll
  for (int i = 0; i < 3; ++i) { int idx = tid + 256 * i; fs[i] = idx / 48; fw[i] = idx % 48; }
  uint4 ra[3];
  const char* gp[3];
  int gst[3];
#pragma unroll
  for (int i = 0; i < 3; ++i) {
    const size_t tok = (size_t)(tokbase + (d ? T - 16 : 0) + fs[i]);
    const u16* src = fw[i] < 24 ? ops_s + (tok * 8 + h) * 192 + fw[i] * 8
                                : ops_d + ((tok * 8 + h) * 2 + d) * 192 + (fw[i] - 24) * 8;
    gp[i] = (const char*)src;
    gst[i] = (fw[i] < 24 ? 16 * 8 * 192 * 2 : 16 * 8 * 2 * 192 * 2) * (d ? -1 : 1);
  }
  auto gload = [&](int c) __attribute__((always_inline)) {
    (void)c;
#pragma unroll
    for (int i = 0; i < 3; ++i) { ra[i] = *(const uint4*)gp[i]; gp[i] += gst[i]; }
  };
  auto lstore = [&](int buf) __attribute__((always_inline)) {
#pragma unroll
    for (int i = 0; i < 3; ++i) {
      char* st = lds + buf * MS_BUF + fs[i] * MS_STEP;
      const int ty = fw[i] >> 3, c = fw[i] & 7;
      if (ty < 2) {
        const int hi4 = ((c >> 1) & 1) * 4;
        const int p1 = ((c >> 2) * 4 + ((2 * c) & 3)) * 8 + hi4;
        const int p2 = ((c >> 2) * 4 + ((2 * c + 1) & 3)) * 8 + hi4;
        char* base = st + ty * 128;
        *(uint2*)(base + p1 * 2) = make_uint2(ra[i].x, ra[i].y);
        *(uint2*)(base + p2 * 2) = make_uint2(ra[i].z, ra[i].w);
      } else if (ty == 2) {
        *(uint4*)(st + 256 + c * 16) = ra[i];
      } else if (ty == 3) {
        float* wdst = (float*)(st + 640) + c * 8;
        *(float4*)wdst = make_float4(hlo(ra[i].x), hhi(ra[i].x), hlo(ra[i].y), hhi(ra[i].y));
        *(float4*)(wdst + 4) = make_float4(hlo(ra[i].z), hhi(ra[i].z), hlo(ra[i].w), hhi(ra[i].w));
      } else {
        const uint32_t flip = (ty == 5) ? 0x80008000u : 0u;
        u16* kdst = (u16*)(st + 384) + c * 16 + (ty == 5 ? 1 : 0);
        const uint32_t x0 = ra[i].x ^ flip, x1 = ra[i].y ^ flip, x2 = ra[i].z ^ flip, x3 = ra[i].w ^ flip;
        kdst[0] = (u16)(x0 & 0xFFFFu);  kdst[2] = (u16)(x0 >> 16);
        kdst[4] = (u16)(x1 & 0xFFFFu);  kdst[6] = (u16)(x1 >> 16);
        kdst[8] = (u16)(x2 & 0xFFFFu);  kdst[10] = (u16)(x2 >> 16);
        kdst[12] = (u16)(x3 & 0xFFFFu); kdst[14] = (u16)(x3 >> 16);
      }
    }
  };
  gload(0);
  lstore(0);
  __syncthreads();
  const int sel = lane & 3;
  const unsigned fragoff = (unsigned)q * 16u;
  const unsigned qmask = (q == 0) ? 0xFFFFFFFFu : 0u;
  const char* rprev = lds + MS_ZERO;
  float yk[4] = {0.f, 0.f, 0.f, 0.f};
  auto yflush = [&](int tprev0) {
#pragma unroll
    for (int a = 0; a < 4; ++a) ybase[(size_t)(tprev0 + 4 * a + q) * 512] = f2bf(yk[a]);
  };
  struct MOps { bf16x8 a0, a1; unsigned vv; uint32_t kdb[4]; };
  const bool sel0 = sel == 0, sel1 = sel == 1;
  auto mload = [&](const char* L, const char* rp) __attribute__((always_inline)) {
    MOps o;
    const unsigned offL = (unsigned)(L - lds) + fragoff, offR = (unsigned)(rp - lds) + 128u + fragoff;
    const unsigned aoff = sel0 ? offL : (sel1 ? offR : (unsigned)MS_ZERO);
    const char* aptr = lds + aoff;
    o.a0 = *(const bf16x8*)aptr;
    o.a1 = *(const bf16x8*)(aptr + 64);
    o.vv = *(const u16*)(L + 256 + row * 2);
#pragma unroll
    for (int kt = 0; kt < 4; ++kt) {
      o.kdb[kt] = *(const uint32_t*)(L + 384 + (16 * kt + vr) * 4);
    }
    return o;
  };
  for (int c = 0; c < nchunks; ++c) {
    const bool more = c + 1 < nchunks;
    if (more) gload(c + 1);
    const char* L0 = lds + (c & 1) * MS_BUF;
    MOps ring[2];
    ring[0] = mload(L0 + (d ? 15 : 0) * MS_STEP, rprev);
#pragma unroll
    for (int s = 0; s < 16; ++s) {
      const int li = d ? 15 - s : s;
      const char* L = L0 + li * MS_STEP;
      if (s < 15) ring[(s + 1) & 1] = mload(L0 + (d ? 14 - s : s + 1) * MS_STEP, L);
      f32x4 w4[4];
#pragma unroll
      for (int kt = 0; kt < 4; ++kt) w4[kt] = *(const f32x4*)(L + 640 + (16 * kt + 4 * q) * 4);
      __builtin_amdgcn_sched_barrier(0);
      const MOps& cur = ring[s & 1];
      uint4 pb0 = make_uint4(pack2bf(S[0][0], S[0][1]), pack2bf(S[0][2], S[0][3]), pack2bf(S[1][0], S[1][1]), pack2bf(S[1][2], S[1][3]));
      uint4 pb1 = make_uint4(pack2bf(S[2][0], S[2][1]), pack2bf(S[2][2], S[2][3]), pack2bf(S[3][0], S[3][1]), pack2bf(S[3][2], S[3][3]));
      f32x4 D = {0.f, 0.f, 0.f, 0.f};
      D = __builtin_amdgcn_mfma_f32_16x16x32_bf16(cur.a0, __builtin_bit_cast(bf16x8, pb0), D, 0, 0, 0);
      D = __builtin_amdgcn_mfma_f32_16x16x32_bf16(cur.a1, __builtin_bit_cast(bf16x8, pb1), D, 0, 0, 0);
      const float u = D[0], yprev = D[1];
      {
        const int pi = (s == 0) ? (d ? 0 : 15) : (d ? 16 - s : s - 1);
        yk[pi >> 2] = (q == (pi & 3)) ? yprev : yk[pi >> 2];
        if (s == 0 && c > 0) yflush(d ? T - 16 * c : 16 * (c - 1));
      }
      const uint32_t b3w = (cur.vv | (pack2bf(u, 0.f) << 16)) & qmask;
      const uint4 b3v = make_uint4(b3w, 0u, 0u, 0u);
      const bf16x8 B3 = __builtin_bit_cast(bf16x8, b3v);
#pragma unroll
      for (int kt = 0; kt < 4; ++kt) {
        const uint4 a3v = make_uint4(cur.kdb[kt] & qmask, 0u, 0u, 0u);
        const f32x4 C = S[kt] * w4[kt];
        S[kt] = __builtin_amdgcn_mfma_f32_16x16x32_bf16(__builtin_bit_cast(bf16x8, a3v), B3, C, 0, 0, 0);
      }
      rprev = L;
      __builtin_amdgcn_sched_barrier(0);
    }
    if (more) lstore((c + 1) & 1);
    __syncthreads();
  }
  {
    const char* aptr = (sel == 1) ? rprev + 128 + fragoff : lds + MS_ZERO;
    const bf16x8 a0 = *(const bf16x8*)aptr;
    const bf16x8 a1 = *(const bf16x8*)(aptr + 64);
    uint4 pb0 = make_uint4(pack2bf(S[0][0], S[0][1]), pack2bf(S[0][2], S[0][3]), pack2bf(S[1][0], S[1][1]), pack2bf(S[1][2], S[1][3]));
    uint4 pb1 = make_uint4(pack2bf(S[2][0], S[2][1]), pack2bf(S[2][2], S[2][3]), pack2bf(S[3][0], S[3][1]), pack2bf(S[3][2], S[3][3]));
    f32x4 D = {0.f, 0.f, 0.f, 0.f};
    D = __builtin_amdgcn_mfma_f32_16x16x32_bf16(a0, __builtin_bit_cast(bf16x8, pb0), D, 0, 0, 0);
    D = __builtin_amdgcn_mfma_f32_16x16x32_bf16(a1, __builtin_bit_cast(bf16x8, pb1), D, 0, 0, 0);
    const int pi = d ? 0 : 15;
    yk[pi >> 2] = (q == (pi & 3)) ? D[1] : yk[pi >> 2];
    yflush(d ? 0 : T - 16);
  }
  if (ctx) {
    float* so = p.out + (d ? 13631488 : 12582912) + ((size_t)(b * 8 + h) * 64 + row) * 64 + 4 * q;
#pragma unroll
    for (int kt = 0; kt < 4; ++kt) *(f32x4*)(so + 16 * kt) = S[kt];
  }
  __syncthreads();
}

DEVINL void scan_dispatch(const Params& p, int unit, char* lds) {
  int T, tokbase, b, h, d, qq;
  bool ctx;
  if (unit < 128) { qq = unit & 3; d = (unit >> 2) & 1; h = (unit >> 3) & 7; b = unit >> 6; T = 2048; tokbase = NCTX + b * 2048; ctx = false; }
  else { const int u = unit - 128; qq = u & 3; d = (u >> 2) & 1; h = (u >> 3) & 7; b = u >> 6; T = 256; tokbase = b * 256; ctx = true; }
  if (!ctx) __builtin_amdgcn_s_setprio(3);
  if (d) scan_unit<1>(p, T, tokbase, b, h, qq, ctx, lds);
  else scan_unit<0>(p, T, tokbase, b, h, qq, ctx, lds);
  if (!ctx) __builtin_amdgcn_s_setprio(0);
}

DEVINL void scan_dispatch_mfma(const Params& p, int unit, char* lds) {
  const bool ctx = unit >= 32;
  const int u = ctx ? unit - 32 : unit;
  const int d = u & 1, h = (u >> 1) & 7, b = u >> 4;
  const int T = ctx ? 256 : 2048;
  const int tokbase = ctx ? b * 256 : NCTX + b * 2048;
  if (d) scan_unit_mfma<1>(p, T, tokbase, b, h, ctx, lds);
  else scan_unit_mfma<0>(p, T, tokbase, b, h, ctx, lds);
}

DEVINL void post_item(const Params& p, int item, int lane) {
  const int r = lane & 15, q = lane >> 4;
  const u16* proj = (const u16*)(p.ws + OFF_PROJ);
  const u16* ops_s = (const u16*)(p.ws + OFF_OPS_S);
  const float* bonus = (const float*)(p.ws + OFF_BONUS);
  u16* mixed = (u16*)(p.ws + OFF_H);
  {
    const int tile = item >> 3, h = item & 7;
    const size_t m = (size_t)tile * 16 + r;
    float y[16];
    float sum = 0.f;
#pragma unroll
    for (int mt = 0; mt < 4; ++mt) {
      const int ch = h * 64 + 16 * mt + 4 * q;
      uint2 ya = *(const uint2*)(ybuf_ptr(p, 0, m) + ch);
      uint2 yb = *(const uint2*)(ybuf_ptr(p, 1, m) + ch);
      y[4 * mt + 0] = bflo(ya.x) + bflo(yb.x); y[4 * mt + 1] = bfhi(ya.x) + bfhi(yb.x); y[4 * mt + 2] = bflo(ya.y) + bflo(yb.y); y[4 * mt + 3] = bfhi(ya.y) + bfhi(yb.y);
      sum += y[4 * mt] + y[4 * mt + 1] + y[4 * mt + 2] + y[4 * mt + 3];
    }
    sum += __shfl_xor(sum, 16);
    sum += __shfl_xor(sum, 32);
    const float mean = sum * (1.f / 64.f);
    float var = 0.f;
#pragma unroll
    for (int i = 0; i < 16; ++i) { float dlt = y[i] - mean; var += dlt * dlt; }
    var += __shfl_xor(var, 16);
    var += __shfl_xor(var, 32);
    const float rstd = rsqrtf(var * (1.f / 64.f) + 64e-5f);
    const float bon = bonus[m * 8 + h];
#pragma unroll
    for (int mt = 0; mt < 4; ++mt) {
      const int c = 16 * mt + 4 * q, ch = h * 64 + c;
      float4 gg = *(const float4*)(p.gn_g + ch);
      float4 gb = *(const float4*)(p.gn_b + ch);
      uint2 vv = *(const uint2*)(ops_s + (m * 8 + h) * 192 + 128 + c);
      uint2 gr = *(const uint2*)(proj + m * NPROJ + 1664 + ch);
      float o0 = ((y[4 * mt + 0] - mean) * rstd * gg.x + gb.x + bon * bflo(vv.x)) * silu_f(bflo(gr.x));
      float o1 = ((y[4 * mt + 1] - mean) * rstd * gg.y + gb.y + bon * bfhi(vv.x)) * silu_f(bfhi(gr.x));
      float o2 = ((y[4 * mt + 2] - mean) * rstd * gg.z + gb.z + bon * bflo(vv.y)) * silu_f(bflo(gr.y));
      float o3 = ((y[4 * mt + 3] - mean) * rstd * gg.w + gb.w + bon * bfhi(vv.y)) * silu_f(bfhi(gr.y));
      *(uint2*)(mixed + kb_off(NTOK, (int)m, ch)) = pack4bf(o0, o1, o2, o3);
    }
  }
}
__device__ void phase5_latent(const Params& p) {
  const int tid = tid_opaque(), lane = tid & 63, w = tid >> 6;
  for (int it = blockIdx.x * 4 + w; it < 2048; it += gridDim.x * 4) post_item(p, 4096 + it, lane);
}

DEVINL void outproj_tile(const Params& p, int id, char* lds) {
  const u16* wot = (const u16*)(p.ws + OFF_WOT);
  const u16* mixed = (const u16*)(p.ws + OFF_H);
  const float* mod = (const float*)(p.ws + OFF_MOD);
  const float* rowtab = (const float*)(p.ws + OFF_ROWTAB);
  const float* coltab = (const float*)(p.ws + OFF_COLTAB);
  const float* xp = p.x_prompt; const float* xs = p.x_sample;
  float* out = p.out;
  {
    const int mg = id >> 6, rem = id & 63;
    const int nt = rem >> 3, mt = mg * 8 + (rem & 7);
    const int n0 = nt * 128, m0 = mt * 128;
    f32x4 acc[4][4];
    gemm_core(wot + (size_t)n0 * 64, (size_t)1024 * 128, mixed + (size_t)m0 * 64, (size_t)NTOK * 128, 16, lds, acc);
    const int tid = tid_opaque(), lane = tid & 63, w = tid >> 6, wp = w >> 1, wq = w & 1, fr = lane & 15, fq = lane >> 4;
    const bool lat = m0 >= NCTX;
    const int mi = lat ? 1 + ((m0 - NCTX) >> 11) : 0;
    const int nb = n0 + 64 * wp + 4 * fq;
    const int mb = m0 + 64 * wq + fr;
    float4 g4[4];
#pragma unroll
    for (int i = 0; i < 4; ++i) g4[i] = *(const float4*)(mod + mi * 3072 + 2048 + nb + 16 * i);
#pragma unroll
    for (int jh = 0; jh < 2; ++jh) {
      float4 x4[4][2], e4[4][2];
#pragma unroll
      for (int i = 0; i < 4; ++i)
#pragma unroll
        for (int jj = 0; jj < 2; ++jj) {
          const int m = mb + 16 * (2 * jh + jj), n = nb + 16 * i;
          if (!lat) {
            x4[i][jj] = *(const float4*)(xp + (size_t)m * 1024 + n);
            e4[i][jj] = make_float4(0.f, 0.f, 0.f, 0.f);
          } else {
            const int mp = m - NCTX, t = mp & 2047;
            x4[i][jj] = *(const float4*)(xs + (size_t)mp * 1024 + n);
            const float* e = n < 512 ? rowtab + (t >> 6) * 512 + n : coltab + (t & 63) * 512 + (n - 512);
            e4[i][jj] = *(const float4*)e;
          }
        }
#pragma unroll
      for (int i = 0; i < 4; ++i)
#pragma unroll
        for (int jj = 0; jj < 2; ++jj) {
          const int m = mb + 16 * (2 * jh + jj), n = nb + 16 * i;
          const f32x4 v = acc[i][2 * jh + jj];
          float4 o = make_float4(x4[i][jj].x + e4[i][jj].x + g4[i].x * v[0], x4[i][jj].y + e4[i][jj].y + g4[i].y * v[1],
                                 x4[i][jj].z + e4[i][jj].z + g4[i].z * v[2], x4[i][jj].w + e4[i][jj].w + g4[i].w * v[3]);
          *(float4*)(out + (size_t)m * 1024 + n) = o;
        }
    }
  }
}
__device__ void phase6_latent(const Params& p, char* lds) {
  constexpr int ID0 = 512, NTILES = 256;
  int first, step, last;
  if ((gridDim.x & 7) == 0) { const int per = NTILES / 8, x = blockIdx.x & 7; first = x * per + (blockIdx.x >> 3); step = gridDim.x >> 3; last = (x + 1) * per; }
  else { first = blockIdx.x; step = gridDim.x; last = NTILES; }
  for (int id = first; id < last; id += step) outproj_tile(p, ID0 + id, lds);
}

DEVINL void final_row(const Params& p, int m, int lane) {
  {
    float* rowp = p.out + (size_t)m * 1024;
    float4 v[4];
    float ss = 0.f;
#pragma unroll
    for (int i = 0; i < 4; ++i) {
      v[i] = *(const float4*)(rowp + lane * 4 + 256 * i);
      ss += v[i].x * v[i].x + v[i].y * v[i].y + v[i].z * v[i].z + v[i].w * v[i].w;
    }
    ss = wave_sum(ss);
    const float rstd = rsqrtf(ss * (1.f / 1024.f) + 1e-6f);
#pragma unroll
    for (int i = 0; i < 4; ++i) {
      float4 g4 = *(const float4*)(p.fng + lane * 4 + 256 * i);
      *(float4*)(rowp + lane * 4 + 256 * i) = make_float4(v[i].x * rstd * g4.x, v[i].y * rstd * g4.y, v[i].z * rstd * g4.z, v[i].w * rstd * g4.w);
    }
  }
}
__device__ void phase7_latent(const Params& p) {
  const int tid = tid_opaque(), lane = tid & 63, w = tid >> 6;
  for (int m = NCTX + blockIdx.x * 4 + w; m < NTOK; m += gridDim.x * 4) final_row(p, m, lane);
}

__device__ void phase4(const Params& p, char* lds) {
  const int tid = tid_opaque(), lane = tid & 63, w = tid >> 6;
  int* cnt = (int*)(p.ws + OFF_CNT);
  int role;
  if (gridDim.x == 512) {
    const int x = blockIdx.x & 7, i = blockIdx.x >> 3;
    const bool lat = i < 32 ? ((i & 3) == 0) : ((i & 3) == 2);
    role = lat ? x * 16 + (i >> 2) : (1 << 20);
  } else {
    role = next_unit(cnt + 1, lds);
  }
  if (role < 128) {
    scan_dispatch(p, role, lds);
  } else {
  XcdBarrier wb = xcd_barrier_post((unsigned*)(p.ws + OFF_BAR2), (volatile LAS unsigned*)(lds + 65536 + 32), gridDim.x - 128);
  int nst = 5;
  asm volatile("" : "+s"(nst));
  for (int stage = 0; stage < nst; ++stage) {
    const int nunits = stage == 0 ? 256 + 1024 : stage == 1 ? 512 + 128 : stage == 2 ? 1024 : 512;
    for (;;) {
      const int u = next_unit(cnt + 2 + stage, lds);
      if (u >= nunits) break;
      if (stage == 0) { if (u < 256) fnet_tile(p, false, u, lds); else prep_item(p, (u - 256) * 4 + w, lane); }
      else if (stage == 1) { if (u < 512) scan_dispatch_mfma(p, 32 + u, lds); else fnet_tile(p, true, u - 512, lds); }
      else if (stage == 2) post_item(p, u * 4 + w, lane);
      else if (stage == 3) outproj_tile(p, u, lds);
      else { const int m0 = u * 16 + w * 4; for (int i = 0; i < 4; ++i) final_row(p, m0 + i, lane); }
    }
    if (stage + 1 < nst) xcd_barrier(wb);
  }
  }
}

__global__ void __launch_bounds__(THREADS, 2) fwd_megakernel(Params p) {
  extern __shared__ __attribute__((aligned(16))) char lds[];
  if (p.use_cg) cg::this_grid().sync();
  if (threadIdx.x == 0) { *(uint4*)(lds + 65536 + 16) = make_uint4(0u, 0u, 0u, 0u); *(uint4*)(lds + 65536 + 32) = make_uint4(0u, 0u, 0u, 0u); }
  __syncthreads();
  XcdBarrier bar = xcd_barrier_post((unsigned*)(p.ws + OFF_BAR), (volatile LAS unsigned*)(lds + 65536 + 16), gridDim.x);
  phase0(p, lds);
  xcd_barrier(bar);
  phase1(p, lds);
  xcd_barrier(bar);
  phase2_all(p, lds);
  xcd_barrier(bar);
  phase3_latent(p);
  xcd_barrier(bar);
  phase4(p, lds);
  xcd_barrier(bar);
  phase5_latent(p);
  xcd_barrier(bar);
  phase6_latent(p, lds);
  xcd_barrier(bar);
  phase7_latent(p);
}

extern "C" void kernel_launch(void* const* d_in, const int* in_sizes, int n_in, void* d_out, int out_size, void* d_ws, size_t ws_size,
                              hipStream_t stream) {
  static int grid_blocks = 0;
  if (grid_blocks == 0) {
    if (n_in != 24 || ws_size < WS_NEED) {
      fprintf(stderr, "kernel_launch: need 24 inputs and >= %zu bytes of workspace (got %d, %zu)\n", (size_t)WS_NEED, n_in, ws_size);
      grid_blocks = -1;
      return;
    }
    int dev = 0, cus = 0, per_cu = 0;
    hipGetDevice(&dev);
    hipDeviceGetAttribute(&cus, hipDeviceAttributeMultiprocessorCount, dev);
    if (hipFuncSetAttribute((const void*)fwd_megakernel, hipFuncAttributeMaxDynamicSharedMemorySize, LDS_BYTES) != hipSuccess) {
      fprintf(stderr, "kernel_launch: hipFuncSetAttribute failed\n");
      grid_blocks = -1;
      return;
    }
    hipOccupancyMaxActiveBlocksPerMultiprocessor(&per_cu, (const void*)fwd_megakernel, THREADS, LDS_BYTES);
    if (per_cu < 1) { fprintf(stderr, "kernel_launch: occupancy query returned %d\n", per_cu); grid_blocks = -1; return; }
    if (per_cu > 2) per_cu = 2;
    grid_blocks = cus * per_cu;
  }
  if (grid_blocks < 0) return;
  hipMemsetAsync(d_ws, 0, ZERO_BYTES, stream);
  Params p{};
  const float* const* in = (const float* const*)d_in;
  p.x_prompt = in[0]; p.x_sample = in[1]; p.st_f = in[2]; p.st_b = in[3]; p.c = in[4]; p.c_ctx = in[5]; p.w_ada = in[6]; p.b_ada = in[7];
  p.norm_g = in[8]; p.w_in = in[9]; p.mu = in[10]; p.w0 = in[11]; p.w2 = in[12]; p.a0 = in[13]; p.a2 = in[14]; p.k_k = in[15]; p.k_a = in[16];
  p.r_k = in[17]; p.gn_g = in[18]; p.gn_b = in[19]; p.w_fnet = in[20]; p.b_fnet = in[21]; p.w_out = in[22]; p.fng = in[23];
  p.out = (float*)d_out;
  p.ws = (char*)d_ws;
  void* args[] = {&p};
  hipError_t e = hipLaunchCooperativeKernel((const void*)fwd_megakernel, dim3(grid_blocks), dim3(THREADS), args, LDS_BYTES, stream);
  if (e != hipSuccess) fprintf(stderr, "cooperative launch failed: %s (grid %d)\n", hipGetErrorString(e), grid_blocks);
}
```

```cpp
#include <hip/hip_runtime.h>
#include <hip/hip_cooperative_groups.h>
#include <cstdio>
#include <cstdint>
namespace cg = cooperative_groups;

#define DEVINL __device__ __forceinline__
typedef unsigned short u16;
typedef __attribute__((ext_vector_type(8))) short bf16x8;
typedef __attribute__((ext_vector_type(4))) float f32x4;
typedef __attribute__((ext_vector_type(2))) float f32x2;
typedef __attribute__((ext_vector_type(2))) __bf16 bf16x2v;

constexpr int NTOK = 12288;
constexpr int NCTX = 8192;
constexpr int NPROJ = 2688;
constexpr int NIN = 3712;
#ifndef LATENT_MFMA
#define LATENT_MFMA 0
#endif
constexpr int THREADS = 256;
constexpr int LDS_BYTES = 65536 + 256;

constexpr size_t OFF_MOD    = 0;
constexpr size_t OFF_CNT    = 36864;
constexpr size_t OFF_BAR    = 36864 + 256;
constexpr size_t OFF_BAR2   = OFF_BAR + 13824;
constexpr size_t ZERO_BYTES = 65536;
static_assert(OFF_BAR2 + 13824 <= ZERO_BYTES, "barrier words");
constexpr size_t OFF_WTIN   = 65536;
constexpr size_t OFF_WOT    = OFF_WTIN + 7602176;
constexpr size_t OFF_W2T    = OFF_WOT + 2097152;
constexpr size_t OFF_ROWTAB = OFF_W2T + 131072;
constexpr size_t OFF_COLTAB = OFF_ROWTAB + 65536;
constexpr size_t OFF_A256   = OFF_COLTAB + 131072;
constexpr size_t OFF_BONUS  = OFF_A256 + 262144;
constexpr size_t OFF_M      = OFF_BONUS + 393216;
constexpr size_t OFF_H      = 11534336;
constexpr size_t OFF_PROJ   = OFF_H + 25165824;
constexpr size_t OFF_OPS_S  = OFF_PROJ + 66060288;
constexpr size_t OFF_OPS_D  = OFF_OPS_S + 37748736;
constexpr size_t OFF_GTL    = OFF_OPS_D + 75497472;
constexpr size_t OFF_A2048  = OFF_GTL + 8388608;
constexpr size_t OFF_GTC    = OFF_A2048 + 16777216;
constexpr size_t OFF_YBUF   = OFF_GTC;
constexpr size_t WS_NEED    = OFF_YBUF + 16777216;
static_assert(OFF_M + 262144 <= OFF_H, "small region overflow");
static_assert(OFF_GTC + 16777216 <= WS_NEED, "alias");
static_assert(WS_NEED <= 268435456, "workspace");

struct Params {
  const float *x_prompt, *x_sample, *st_f, *st_b, *c, *c_ctx, *w_ada, *b_ada, *norm_g, *w_in, *mu, *w0, *w2, *a0, *a2,
      *k_k, *k_a, *r_k, *gn_g, *gn_b, *w_fnet, *b_fnet, *w_out, *fng;
  float* out;
  char* ws;
  int use_cg;
  int pad_;
};

DEVINL uint32_t pack2bf(float a, float b) {
  f32x2 v = {a, b};
  bf16x2v r = __builtin_convertvector(v, bf16x2v);
  return __builtin_bit_cast(uint32_t, r);
}
DEVINL u16 f2bf(float a) { return (u16)(pack2bf(a, 0.f) & 0xFFFFu); }
DEVINL uint2 pack4bf(float a, float b, float c, float d) { return make_uint2(pack2bf(a, b), pack2bf(c, d)); }
DEVINL float bflo(uint32_t w) { return __uint_as_float(w << 16); }
DEVINL float bfhi(uint32_t w) { return __uint_as_float(w & 0xFFFF0000u); }
DEVINL uint32_t pack2h(float a, float b) {
  _Float16 ha = (_Float16)a, hb = (_Float16)b;
  return (uint32_t)__builtin_bit_cast(u16, ha) | ((uint32_t)__builtin_bit_cast(u16, hb) << 16);
}
DEVINL float hlo(uint32_t w) { return (float)__builtin_bit_cast(_Float16, (u16)(w & 0xFFFFu)); }
DEVINL float hhi(uint32_t w) { return (float)__builtin_bit_cast(_Float16, (u16)(w >> 16)); }
DEVINL int tid_opaque() { int t = threadIdx.x; asm volatile("" : "+v"(t)); return t; }
DEVINL size_t kb_off(int R, int row, int k) { return ((size_t)(k >> 6) * R + row) * 64 + (k & 63); }
DEVINL float rcp_f(float x) { return __builtin_amdgcn_rcpf(x); }
DEVINL float sigmoid_f(float x) { return rcp_f(1.f + __expf(-x)); }
DEVINL float silu_f(float x) { return x * sigmoid_f(x); }
DEVINL float amul(float a, float b) { float r; asm("v_mul_f32 %0, %1, %2" : "=v"(r) : "v"(a), "v"(b)); return r; }
DEVINL float afma(float a, float b, float c) { float r; asm("v_fma_f32 %0, %1, %2, %3" : "=v"(r) : "v"(a), "v"(b), "v"(c)); return r; }
DEVINL float afnma(float a, float b, float c) { float r; asm("v_fma_f32 %0, -%1, %2, %3" : "=v"(r) : "v"(a), "v"(b), "v"(c)); return r; }
template <int CTRL>
DEVINL float dpp_f(float x) {
  return __int_as_float(__builtin_amdgcn_update_dpp(0, __float_as_int(x), CTRL, 0xF, 0xF, false));
}
DEVINL float allreduce16(float x) {
  x += dpp_f<0x128>(x);
  x += dpp_f<0x124>(x);
  x += dpp_f<0x122>(x);
  x += dpp_f<0x121>(x);
  return x;
}
DEVINL float wave_sum(float x) {
#pragma unroll
  for (int o = 32; o >= 1; o >>= 1) x += __shfl_xor(x, o);
  return x;
}


#define XB_TMO      128
#define XB_XCNT(j)  (256  + 64 * (j))
#define XB_XSUB(j)  (1280 + 64 * (j))
#define XB_XGEN(j)  (2304 + 64 * (j))
#define XB_TOP      3328
#define XB_TOPGEN   3392
#define XCD_BAR_WORDS 3456
#define XB_SPIN_CAP (1u << 22)
#define LAS __attribute__((address_space(3)))
DEVINL unsigned xb_ld(unsigned* p) { return __hip_atomic_load(p, __ATOMIC_RELAXED, __HIP_MEMORY_SCOPE_AGENT); }
DEVINL unsigned xb_add(unsigned* p, unsigned v) { return __hip_atomic_fetch_add(p, v, __ATOMIC_RELAXED, __HIP_MEMORY_SCOPE_AGENT); }
DEVINL unsigned xb_xcc_id() { return (unsigned)__builtin_amdgcn_s_getreg((3 << 11) | 20) & 0xFu; }
#define XB_SPIN(cond, bar) do { unsigned _sp = 0; while (cond) { __builtin_amdgcn_s_sleep(1); \
    if ((++_sp & 255u) == 0u) { if (xb_ld(&(bar)[XB_TMO])) break; if (_sp > XB_SPIN_CAP) { atomicAdd(&(bar)[XB_TMO], 1u); break; } } } } while (0)
struct XcdBarrier { unsigned* bar; unsigned x; volatile LAS unsigned* st; unsigned total; };
DEVINL XcdBarrier xcd_barrier_post(unsigned* bar, volatile LAS unsigned* st, unsigned total) {
  XcdBarrier b; b.bar = bar; b.x = xb_xcc_id(); b.st = st; b.total = total;
  if (threadIdx.x == 0) (void)xb_add(&bar[XB_XCNT(b.x)], 1u);
  return b;
}
DEVINL void xcd_barrier_complete(unsigned* bar, unsigned x, unsigned G, unsigned& nloc, unsigned& nx) {
  unsigned sum, cnt, mine, sp = 0u;
  for (;;) {
    sum = 0u; cnt = 0u; mine = 0u;
#pragma unroll
    for (unsigned j = 0; j < 16; ++j) { const unsigned c = xb_ld(&bar[XB_XCNT(j)]); sum += c; cnt += (c > 0u) ? 1u : 0u; mine = (j == x) ? c : mine; }
    if (sum == G) break;
    __builtin_amdgcn_s_sleep(1);
    if ((++sp & 255u) == 0u) { if (xb_ld(&bar[XB_TMO])) break; if (sp > XB_SPIN_CAP) { atomicAdd(&bar[XB_TMO], 1u); break; } }
  }
  nloc = mine > 0u ? mine : 1u; nx = cnt > 0u ? cnt : 1u;
}
DEVINL void xcd_barrier(const XcdBarrier& b) {
  asm volatile("s_waitcnt vmcnt(0)" ::: "memory");
  __syncthreads();
  if (threadIdx.x == 0) {
    unsigned* bar = b.bar;
    __builtin_amdgcn_s_waitcnt(0);
    unsigned nloc = b.st[0], nx = b.st[1];
    if (nloc == 0u) { xcd_barrier_complete(bar, b.x, b.total, nloc, nx); b.st[0] = nloc; b.st[1] = nx; }
    const unsigned old = xb_add(&bar[XB_XSUB(b.x)], 1u);
    const unsigned gen = old / nloc;
    if (old + 1u == (gen + 1u) * nloc) {
      __builtin_amdgcn_fence(__ATOMIC_RELEASE, "agent");
      asm volatile("s_waitcnt vmcnt(0)" ::: "memory");
      const unsigned og = xb_add(&bar[XB_TOP], 1u);
      const unsigned tg = og / nx;
      if (og + 1u == (tg + 1u) * nx) xb_add(&bar[XB_TOPGEN], 1u);
      else XB_SPIN(xb_ld(&bar[XB_TOPGEN]) == tg, bar);
      __builtin_amdgcn_fence(__ATOMIC_ACQUIRE, "agent");
      xb_add(&bar[XB_XGEN(b.x)], 1u);
      asm volatile("s_waitcnt vmcnt(0)" ::: "memory");
    } else {
      XB_SPIN(xb_ld(&bar[XB_XGEN(b.x)]) == gen, bar);
      __builtin_amdgcn_fence(__ATOMIC_ACQUIRE, "agent");
      asm volatile("s_waitcnt vmcnt(0)" ::: "memory");
    }
  }
  __syncthreads();
}

DEVINL u16* ybuf_ptr(const Params& p, int d, size_t m) {
  return m < (size_t)NCTX ? (u16*)(p.ws + OFF_YBUF) + ((size_t)d * NCTX + m) * 512
                          : (u16*)(p.out + 8388608) + ((size_t)d * 4096 + (m - NCTX)) * 512;
}
DEVINL void unit_done(int* ctr) {
  asm volatile("s_waitcnt vmcnt(0)" ::: "memory");
  __syncthreads();
  if (threadIdx.x == 0) {
    __builtin_amdgcn_fence(__ATOMIC_RELEASE, "agent");
    asm volatile("s_waitcnt vmcnt(0)" ::: "memory");
    (void)xb_add((unsigned*)ctr, 1u);
  }
}
DEVINL void wait_for(int* ctr, int target) {
  if (threadIdx.x == 0) {
    unsigned sp = 0;
    while ((int)xb_ld((unsigned*)ctr) < target) { __builtin_amdgcn_s_sleep(2); if (++sp > (1u << 24)) break; }
    __builtin_amdgcn_fence(__ATOMIC_ACQUIRE, "agent");
    asm volatile("s_waitcnt vmcnt(0)" ::: "memory");
  }
  __syncthreads();
}

#define GT_WAIT(n) asm volatile("s_waitcnt vmcnt(" #n ")" ::: "memory")
DEVINL void gemm_core(const u16* __restrict__ P, size_t ksp, const u16* __restrict__ Q, size_t ksq, int nk, char* lds, f32x4 (&acc)[4][4]) {
  const int tid = tid_opaque(), lane = tid & 63, w = tid >> 6, wp = w >> 1, wq = w & 1;
  const int fr = lane & 15, fq = lane >> 4;
#pragma unroll
  for (int i = 0; i < 4; ++i)
#pragma unroll
    for (int j = 0; j < 4; ++j) acc[i][j] = (f32x4){0.f, 0.f, 0.f, 0.f};
  const char* Pb = (const char*)P;
  const char* Qb = (const char*)Q;
  unsigned so[2];
#pragma unroll
  for (int k = 0; k < 2; ++k) {
    const int R = (2 * w + k) * 16 + (lane >> 2);
    const int c = (lane & 3) ^ ((R & 8) ? 3 : 0);
    so[k] = (unsigned)(R * 128 + c * 16);
  }
  const int nst = nk * 2;
  auto issue = [&](int st) {
    const size_t kb = (size_t)(st >> 1);
    const unsigned kh = (unsigned)(st & 1) * 64u;
    char* dstp = lds + (st & 3) * 16384 + (2 * w) * 1024;
    const char* ps = Pb + kb * ksp + kh;
    const char* qs = Qb + kb * ksq + kh;
    __builtin_amdgcn_global_load_lds((const unsigned*)(ps + so[0]), (unsigned*)(dstp), 16, 0, 0);
    __builtin_amdgcn_global_load_lds((const unsigned*)(ps + so[1]), (unsigned*)(dstp + 1024), 16, 0, 0);
    __builtin_amdgcn_global_load_lds((const unsigned*)(qs + so[0]), (unsigned*)(dstp + 8192), 16, 0, 0);
    __builtin_amdgcn_global_load_lds((const unsigned*)(qs + so[1]), (unsigned*)(dstp + 8192 + 1024), 16, 0, 0);
  };
  issue(0);
  issue(1);
  issue(2);
  const int sw = (fr & 8) ? 3 : 0;
  const int roff = fr * 64 + ((fq ^ sw) << 4);
  for (int st = 0; st < nst; ++st) {
    if (st + 2 < nst) GT_WAIT(8); else if (st + 1 < nst) GT_WAIT(4); else GT_WAIT(0);
    __builtin_amdgcn_s_barrier();
    if (st + 3 < nst) issue(st + 3);
    const char* bp = lds + (st & 3) * 16384;
    const char* bq = bp + 8192;
    bf16x8 a[4], b[4];
#pragma unroll
    for (int i = 0; i < 4; ++i) {
      a[i] = *(const bf16x8*)(bp + (64 * wp + 16 * i) * 64 + roff);
      b[i] = *(const bf16x8*)(bq + (64 * wq + 16 * i) * 64 + roff);
    }
#pragma unroll
    for (int i = 0; i < 4; ++i)
#pragma unroll
      for (int j = 0; j < 4; ++j) acc[i][j] = __builtin_amdgcn_mfma_f32_16x16x32_bf16(a[i], b[j], acc[i][j], 0, 0, 0);
  }
  __syncthreads();
}
template <class Epi>
DEVINL void gemm_tile(const u16* __restrict__ P, size_t ksp, const u16* __restrict__ Q, size_t ksq, int nk, char* lds, Epi epi) {
  f32x4 acc[4][4];
  gemm_core(P, ksp, Q, ksq, nk, lds, acc);
  const int tid = tid_opaque(), lane = tid & 63, w = tid >> 6, wp = w >> 1, wq = w & 1;
  const int fr = lane & 15, fq = lane >> 4;
#pragma unroll
  for (int i = 0; i < 4; ++i)
#pragma unroll
    for (int j = 0; j < 4; ++j) epi(64 * wp + 16 * i + 4 * fq, 64 * wq + 16 * j + fr, acc[i][j]);
}

DEVINL void transpose_unit(const float* __restrict__ src, int ld, int k0, int c0, u16* __restrict__ dst, int R, int n0, float* tile) {
  const int tid = tid_opaque();
#pragma unroll 4
  for (int i = 0; i < 16; ++i) {
    int kk = (tid >> 6) + 4 * i, nn = tid & 63;
    tile[kk * 65 + nn] = src[(size_t)(k0 + kk) * ld + c0 + nn];
  }
  __syncthreads();
#pragma unroll
  for (int i = 0; i < 2; ++i) {
    int nn = (tid >> 3) + 32 * i, kc = tid & 7;
    const float* t = tile + (kc * 8) * 65 + nn;
    uint4 o;
    o.x = pack2bf(t[0], t[65]);
    o.y = pack2bf(t[130], t[195]);
    o.z = pack2bf(t[260], t[325]);
    o.w = pack2bf(t[390], t[455]);
    *(uint4*)(dst + kb_off(R, n0 + nn, k0 + kc * 8)) = o;
  }
  __syncthreads();
}

__device__ void phase0(const Params& p, char* lds) {
  const int tid = tid_opaque();
  float* ldsf = (float*)lds;
  float* mod = (float*)(p.ws + OFF_MOD);
  constexpr int NU_M = 64, NU_MOD = 384, NU_TIN = 672, NU_TOUT = 256;
  constexpr int NU = NU_M + NU_MOD + NU_TIN + NU_TOUT;
  for (int u = blockIdx.x; u < NU; u += gridDim.x) {
    if (u < NU_M) {
      const int g = u >> 3, c8 = u & 7;
      float* tabc = ldsf; float* tabs = ldsf + 64;
      if (tid < 64) { float s, c; sincospif((float)tid * (1.f / 32.f), &s, &c); tabc[tid] = c; tabs[tid] = s; }
      __syncthreads();
      const int j2 = tid & 127, jj = j2 & 63;
      const float* tab = (j2 >> 6) ? tabs : tabc;
      const float* wf = p.w_fnet + (size_t)g * 4096 + jj;
      float* Mo = (float*)(p.ws + OFF_M) + (size_t)g * 8192;
      {
        const int cb = c8 * 8 + (tid >> 7);
        float s0 = 0.f, s1 = 0.f, s2 = 0.f, s3 = 0.f;
#pragma unroll 16
        for (int e = 0; e < 64; ++e) {
          const float wv = wf[e * 64];
          s0 += tab[(cb * e) & 63] * wv;
          s1 += tab[((cb + 2) * e) & 63] * wv;
          s2 += tab[((cb + 4) * e) & 63] * wv;
          s3 += tab[((cb + 6) * e) & 63] * wv;
        }
        Mo[cb * 128 + j2] = s0; Mo[(cb + 2) * 128 + j2] = s1; Mo[(cb + 4) * 128 + j2] = s2; Mo[(cb + 6) * 128 + j2] = s3;
      }
      __syncthreads();
    } else if (u < NU_M + NU_MOD) {
      const int v = u - NU_M;
      const int cb = v % 12, ks = v / 12;
      const int col = cb * 256 + tid;
      float a0 = 0.f, a1 = 0.f, a2 = 0.f;
      if (tid < 96) {
        const int kk = ks * 32 + (tid & 31), which = tid >> 5;
        const float cv = which == 0 ? p.c_ctx[kk] : p.c[(which - 1) * 1024 + kk];
        ldsf[tid] = silu_f(cv);
      }
      __syncthreads();
#pragma unroll 8
      for (int k = 0; k < 32; ++k) {
        float wv = p.w_ada[(size_t)(ks * 32 + k) * 3072 + col];
        a0 += ldsf[k] * wv;
        a1 += ldsf[32 + k] * wv;
        a2 += ldsf[64 + k] * wv;
      }
      __syncthreads();
      if (ks == 0) { float bb = p.b_ada[col]; a0 += bb; a1 += bb; a2 += bb; }
      unsafeAtomicAdd(&mod[col], a0);
      unsafeAtomicAdd(&mod[3072 + col], a1);
      unsafeAtomicAdd(&mod[6144 + col], a2);
    } else if (u < NU_M + NU_MOD + NU_TIN) {
      const int v = u - NU_M - NU_MOD;
      const int ktile = v & 15, ntile = v >> 4;
      const int n0 = ntile * 64;
      const int c0 = n0 < 2176 ? n0 : n0 + 512;
      transpose_unit(p.w_in, 3200, ktile * 64, c0, (u16*)(p.ws + OFF_WTIN), NIN, n0, ldsf);
    } else {
      const int v = u - NU_M - NU_MOD - NU_TIN;
      const int ktile = v & 15, ntile = v >> 4;
      transpose_unit(p.w_out, 1024, ktile * 64, ntile * 64, (u16*)(p.ws + OFF_WOT), 1024, ntile * 64, ldsf);
    }
  }
  const int gt = blockIdx.x * THREADS + tid, gn = gridDim.x * THREADS;
  {
    u16* w2t = (u16*)(p.ws + OFF_W2T);
    for (int i = gt; i < 65536; i += gn) {
      int j = i & 31, c = (i >> 5) & 511, combo = i >> 14;
      int d = combo >> 1;
      const float* src = (combo & 1) ? p.a2 : p.w2;
      w2t[i] = f2bf(src[((size_t)d * 32 + j) * 512 + c]);
    }
  }
  {
    float* rowtab = (float*)(p.ws + OFF_ROWTAB);
    float* coltab = (float*)(p.ws + OFF_COLTAB);
    for (int i = gt; i < 96 * 256; i += gn) {
      int f = i & 255, pos = i >> 8;
      float freq = expf(-9.210340371976184f * (float)f * (1.f / 256.f));
      float pv = pos < 32 ? (float)pos : (float)(pos - 32);
      float ang = pv * freq;
      float s = sinf(ang), c = cosf(ang);
      float* dst = pos < 32 ? rowtab + pos * 512 : coltab + (pos - 32) * 512;
      dst[f] = s; dst[256 + f] = c;
    }
  }
  {
    u16* a256 = (u16*)(p.ws + OFF_A256);
    for (int i = gt; i < 256 * 256; i += gn) {
      int k = i & 255, tp = i >> 8;
      int m = (tp * k) & 255;
      float s, c; sincospif((float)m * (1.f / 128.f), &s, &c);
      a256[kb_off(256, tp, k)] = f2bf(c);
      a256[kb_off(256, tp, 256 + k)] = f2bf(-s);
    }
    u16* a2048 = (u16*)(p.ws + OFF_A2048);
    __syncthreads();
    float* ctab = ldsf;
    for (int m = tid; m < 2048; m += THREADS) { float sn, cs; sincospif((float)m * (1.f / 1024.f), &sn, &cs); ctab[m] = cs; }
    __syncthreads();
    for (int i = gt; i < 2048 * 2048; i += gn) {
      int k = i & 2047, tp = i >> 11;
      int m = (tp * k) & 2047;
      a2048[kb_off(2048, tp, k)] = f2bf(ctab[m]);
      a2048[kb_off(2048, tp, 2048 + k)] = f2bf(-ctab[(m - 512) & 2047]);
    }
  }
}

__device__ void phase1(const Params& p, char* lds) {
  const int tid = tid_opaque(), lane = tid & 63, w = tid >> 6;
  float* ldsf = (float*)lds;
  const float* mod = (const float*)(p.ws + OFF_MOD);
  const float* rowtab = (const float*)(p.ws + OFF_ROWTAB);
  const float* coltab = (const float*)(p.ws + OFF_COLTAB);
  u16* hbuf = (u16*)(p.ws + OFF_H);
  constexpr int NU_FOLD = 512, NU_ROWS = NTOK / 8;
  for (int u = blockIdx.x; u < NU_FOLD + NU_ROWS; u += gridDim.x) {
    if (u < NU_FOLD) {
      const int g = u >> 6, k0 = ((u >> 2) & 15) * 64, jq = (u & 3) * 32;
      float* Ml = ldsf;
      float* Wl = ldsf + 2048;
      const float* Mg = (const float*)(p.ws + OFF_M) + (size_t)g * 8192 + jq;
      for (int i = tid; i < 512; i += THREADS) ((float4*)Ml)[i] = *(const float4*)(Mg + (i >> 3) * 128 + (i & 7) * 4);
#pragma unroll 4
      for (int i = 0; i < 16; ++i) {
        int kk = (tid >> 6) + 4 * i, cc = tid & 63;
        Wl[kk * 65 + cc] = p.w_in[(size_t)(k0 + kk) * 3200 + 2176 + g * 64 + cc];
      }
      __syncthreads();
      u16* dst = (u16*)(p.ws + OFF_WTIN);
      for (int grp = 0; grp < 2; ++grp) {
        const int jl = w * 8 + grp * 4;
        float s0 = 0.f, s1 = 0.f, s2 = 0.f, s3 = 0.f;
#pragma unroll 8
        for (int cc = 0; cc < 64; ++cc) {
          float wl = Wl[lane * 65 + cc];
          float4 m4 = *(const float4*)(Ml + cc * 32 + jl);
          s0 += wl * m4.x; s1 += wl * m4.y; s2 += wl * m4.z; s3 += wl * m4.w;
        }
        size_t o = kb_off(NIN, 2688 + g * 128 + jq + jl, k0 + lane);
        dst[o] = f2bf(s0); dst[o + 64] = f2bf(s1); dst[o + 128] = f2bf(s2); dst[o + 192] = f2bf(s3);
      }
      __syncthreads();
    } else {
      const int mb = (u - NU_FOLD) * 8 + w * 2;
      const bool lat = mb >= NCTX;
      const int mi = lat ? 1 + ((mb - NCTX) >> 11) : 0;
      float4 v[2][4];
      float ss[2] = {0.f, 0.f};
#pragma unroll
      for (int rr = 0; rr < 2; ++rr) {
        const int m = mb + rr, mp = m - NCTX, t = mp & 2047;
        const float* xr = lat ? p.x_sample + (size_t)mp * 1024 : p.x_prompt + (size_t)m * 1024;
#pragma unroll
        for (int i = 0; i < 4; ++i) {
          const int col = lane * 4 + 256 * i;
          v[rr][i] = *(const float4*)(xr + col);
          if (lat) {
            const float* e = col < 512 ? rowtab + (t >> 6) * 512 + col : coltab + (t & 63) * 512 + (col - 512);
            float4 e4 = *(const float4*)e;
            v[rr][i].x += e4.x; v[rr][i].y += e4.y; v[rr][i].z += e4.z; v[rr][i].w += e4.w;
          }
          ss[rr] += v[rr][i].x * v[rr][i].x + v[rr][i].y * v[rr][i].y + v[rr][i].z * v[rr][i].z + v[rr][i].w * v[rr][i].w;
        }
      }
      ss[0] = wave_sum(ss[0]);
      ss[1] = wave_sum(ss[1]);
      const float rstd0 = rsqrtf(ss[0] * (1.f / 1024.f) + 1e-6f), rstd1 = rsqrtf(ss[1] * (1.f / 1024.f) + 1e-6f);
#pragma unroll
      for (int i = 0; i < 4; ++i) {
        const int col = lane * 4 + 256 * i;
        float4 g4 = *(const float4*)(p.norm_g + col);
        float4 sh = *(const float4*)(mod + mi * 3072 + col);
        float4 sc = *(const float4*)(mod + mi * 3072 + 1024 + col);
        const float gx = g4.x * (1.f + sc.x), gy = g4.y * (1.f + sc.y), gz = g4.z * (1.f + sc.z), gw = g4.w * (1.f + sc.w);
#pragma unroll
        for (int rr = 0; rr < 2; ++rr) {
          const float rstd = rr ? rstd1 : rstd0;
          float h0 = v[rr][i].x * rstd * gx + sh.x;
          float h1 = v[rr][i].y * rstd * gy + sh.y;
          float h2 = v[rr][i].z * rstd * gz + sh.z;
          float h3 = v[rr][i].w * rstd * gw + sh.w;
          *(uint2*)(hbuf + kb_off(NTOK, mb + rr, col)) = pack4bf(h0, h1, h2, h3);
        }
      }
    }
  }
}

DEVINL void inproj_tile(const Params& p, int id, char* lds) {
  const u16* hbuf = (const u16*)(p.ws + OFF_H);
  const u16* wt = (const u16*)(p.ws + OFF_WTIN);
  u16* proj = (u16*)(p.ws + OFF_PROJ);
  u16* gtc = (u16*)(p.ws + OFF_GTC);
  u16* gtl = (u16*)(p.ws + OFF_GTL);
  constexpr int NT = 29;
  constexpr size_t KS_W = (size_t)NIN * 128, KS_H = (size_t)NTOK * 128;
  const int mg = id / (NT * 8), rem = id % (NT * 8);
  const int nt = rem >> 3, mt = mg * 8 + (rem & 7);
  const int m0 = mt * 128, n0 = nt * 128;
  if (nt < 21) {
    f32x4 acc[4][4];
    gemm_core(wt + (size_t)n0 * 64, KS_W, hbuf + (size_t)m0 * 64, KS_H, 16, lds, acc);
    const int tid = tid_opaque(), lane = tid & 63, w = tid >> 6, wp = w >> 1, wq = w & 1, fr = lane & 15, fq = lane >> 4;
    constexpr int CST = 272;
#pragma unroll
    for (int i = 0; i < 4; ++i)
#pragma unroll
      for (int j = 0; j < 4; ++j) {
        const int ql = 64 * wq + 16 * j + fr, pl = 64 * wp + 16 * i + 4 * fq;
        *(uint2*)(lds + ql * CST + pl * 2) = pack4bf(acc[i][j][0], acc[i][j][1], acc[i][j][2], acc[i][j][3]);
      }
    __syncthreads();
#pragma unroll
    for (int k = 0; k < 8; ++k) {
      const int row = (tid >> 4) + 16 * k, c16 = tid & 15;
      const uint4 v = *(const uint4*)(lds + row * CST + c16 * 16);
      *(uint4*)(proj + (size_t)(m0 + row) * NPROJ + n0 + c16 * 8) = v;
    }
    __syncthreads();
  } else {
    const int g = nt - 21;
    f32x4 acc[4][4];
    gemm_core(hbuf + (size_t)m0 * 64, KS_H, wt + (size_t)n0 * 64, KS_W, 16, lds, acc);
    const int tid = tid_opaque(), lane = tid & 63, w = tid >> 6, wp = w >> 1, wq = w & 1, fr = lane & 15, fq = lane >> 4;
    constexpr int CST = 272;
#pragma unroll
    for (int i = 0; i < 4; ++i)
#pragma unroll
      for (int j = 0; j < 4; ++j) {
        const int ql = 64 * wq + 16 * j + fr, pl = 64 * wp + 16 * i + 4 * fq;
        *(uint2*)(lds + ql * CST + pl * 2) = pack4bf(acc[i][j][0], acc[i][j][1], acc[i][j][2], acc[i][j][3]);
      }
    __syncthreads();
    const bool isctx = m0 < NCTX;
    const int bb = isctx ? (m0 >> 8) : ((m0 - NCTX) >> 11);
    const int tb = isctx ? (m0 & 255) : ((m0 - NCTX) & 2047);
#pragma unroll
    for (int k = 0; k < 8; ++k) {
      const int row = (tid >> 4) + 16 * k, c16 = tid & 15;
      const uint4 v = *(const uint4*)(lds + row * CST + c16 * 16);
      const int part = row >> 6, cp = row & 63, t = tb + c16 * 8;
      u16* dst = isctx ? gtc + kb_off(16384, (bb * 8 + g) * 64 + cp, part * 256 + t)
                       : gtl + kb_off(1024, (bb * 8 + g) * 64 + cp, part * 2048 + t);
      *(uint4*)dst = v;
    }
    __syncthreads();
  }
}
__device__ void phase2_all(const Params& p, char* lds) {
  constexpr int NTILES = 29 * 96;
  int first, step, last;
  if ((gridDim.x & 7) == 0) { const int per = NTILES / 8, x = blockIdx.x & 7; first = x * per + (blockIdx.x >> 3); step = gridDim.x >> 3; last = (x + 1) * per; }
  else { first = blockIdx.x; step = gridDim.x; last = NTILES; }
  for (int id = first; id < last; id += step) inproj_tile(p, id, lds);
}

DEVINL void mix4(const u16* prow, bool hasPrev, bool hasNext, const float* mu, int col, float* o) {
  uint2 c = *(const uint2*)(prow + col);
  uint2 pv = make_uint2(0u, 0u), nx = make_uint2(0u, 0u);
  if (hasPrev) pv = *(const uint2*)(prow - NPROJ + col);
  if (hasNext) nx = *(const uint2*)(prow + NPROJ + col);
  float4 m4 = *(const float4*)(mu + col);
  float c0 = bflo(c.x), c1 = bfhi(c.x), c2 = bflo(c.y), c3 = bfhi(c.y);
  o[0] = c0 + m4.x * (0.5f * (bflo(pv.x) + bflo(nx.x)) - c0);
  o[1] = c1 + m4.y * (0.5f * (bfhi(pv.x) + bfhi(nx.x)) - c1);
  o[2] = c2 + m4.z * (0.5f * (bflo(pv.y) + bflo(nx.y)) - c2);
  o[3] = c3 + m4.w * (0.5f * (bfhi(pv.y) + bfhi(nx.y)) - c3);
}
DEVINL void mix8(const u16* prow, bool hasPrev, bool hasNext, const float* mu, int col, float* o) {
  mix4(prow, hasPrev, hasNext, mu, col, o);
  mix4(prow, hasPrev, hasNext, mu, col + 4, o + 4);
}
DEVINL float tanh_f(float x) {
  float e = __expf(2.f * x);
  return 1.f - 2.f * rcp_f(e + 1.f);
}

DEVINL void prep_item(const Params& p, int item, int lane) {
  const int tile = item >> 3, h = item & 7;
  const int r = lane & 15, q = lane >> 4;
  const int m = tile * 16 + r;
  int T, t;
  if (m < NCTX) { T = 256; t = m & 255; } else { T = 2048; t = (m - NCTX) & 2047; }
  const bool hasPrev = t > 0, hasNext = t < T - 1;
  const u16* prow = (const u16*)(p.ws + OFF_PROJ) + (size_t)m * NPROJ;
  const u16* w2t = (const u16*)(p.ws + OFF_W2T);
  u16* ops_s = (u16*)(p.ws + OFF_OPS_S) + ((size_t)m * 8 + h) * 192;
  u16* ops_d = (u16*)(p.ws + OFF_OPS_D) + ((size_t)m * 8 + h) * 384;

  bf16x8 xw[2], xa[2];
#pragma unroll
  for (int d = 0; d < 2; ++d) {
    float t8[8];
    mix8(prow, hasPrev, hasNext, p.mu, 1536 + d * 32 + 8 * q, t8);
#pragma unroll
    for (int e = 0; e < 8; ++e) t8[e] = tanh_f(t8[e]);
    uint4 pk = make_uint4(pack2bf(t8[0], t8[1]), pack2bf(t8[2], t8[3]), pack2bf(t8[4], t8[5]), pack2bf(t8[6], t8[7]));
    xw[d] = __builtin_bit_cast(bf16x8, pk);
    mix8(prow, hasPrev, hasNext, p.mu, 1600 + d * 32 + 8 * q, t8);
    pk = make_uint4(pack2bf(t8[0], t8[1]), pack2bf(t8[2], t8[3]), pack2bf(t8[4], t8[5]), pack2bf(t8[6], t8[7]));
    xa[d] = __builtin_bit_cast(bf16x8, pk);
  }
  float nsq = 0.f;
#pragma unroll 4
  for (int mt = 0; mt < 4; ++mt) {
    const int ch = h * 64 + 16 * mt + 4 * q;
    float kp[4];
    mix4(prow, hasPrev, hasNext, p.mu, 512 + ch, kp);
    float4 kk4 = *(const float4*)(p.k_k + ch);
    float a0 = kp[0] * kk4.x, a1 = kp[1] * kk4.y, a2 = kp[2] * kk4.z, a3 = kp[3] * kk4.w;
    nsq += a0 * a0 + a1 * a1 + a2 * a2 + a3 * a3;
  }
  nsq += __shfl_xor(nsq, 16);
  nsq += __shfl_xor(nsq, 32);
  const float inv = 1.f / fmaxf(sqrtf(nsq), 1e-12f);
  float bon = 0.f;
#pragma unroll 1
  for (int mt = 0; mt < 4; ++mt) {
    const int c = 16 * mt + 4 * q;
    const int ch = h * 64 + c;
    float rp[4], vp[4], kk[4], kp[4];
    mix4(prow, hasPrev, hasNext, p.mu, 512 + ch, kp);
    mix4(prow, hasPrev, hasNext, p.mu, ch, rp);
    mix4(prow, hasPrev, hasNext, p.mu, 1024 + ch, vp);
    {
      float4 kk4 = *(const float4*)(p.k_k + ch);
      kk[0] = kp[0] * kk4.x * inv; kk[1] = kp[1] * kk4.y * inv; kk[2] = kp[2] * kk4.z * inv; kk[3] = kp[3] * kk4.w * inv;
    }
    *(uint2*)(ops_s + c) = pack4bf(kk[0], kk[1], kk[2], kk[3]);
    *(uint2*)(ops_s + 64 + c) = pack4bf(rp[0], rp[1], rp[2], rp[3]);
    *(uint2*)(ops_s + 128 + c) = pack4bf(vp[0], vp[1], vp[2], vp[3]);
    const float4 ka4 = *(const float4*)(p.k_a + ch);
    const float4 rk4 = *(const float4*)(p.r_k + ch);
    const float kav[4] = {ka4.x, ka4.y, ka4.z, ka4.w};
    const float rkv[4] = {rk4.x, rk4.y, rk4.z, rk4.w};
#pragma unroll
    for (int d = 0; d < 2; ++d) {
      bf16x8 aw = *(const bf16x8*)(w2t + ((size_t)((d * 2 + 0) * 512 + h * 64 + 16 * mt + r)) * 32 + 8 * q);
      bf16x8 aa = *(const bf16x8*)(w2t + ((size_t)((d * 2 + 1) * 512 + h * 64 + 16 * mt + r)) * 32 + 8 * q);
      f32x4 z0 = {0.f, 0.f, 0.f, 0.f};
      f32x4 zw = __builtin_amdgcn_mfma_f32_16x16x32_bf16(aw, xw[d], z0, 0, 0, 0);
      f32x4 za = __builtin_amdgcn_mfma_f32_16x16x32_bf16(aa, xa[d], z0, 0, 0, 0);
      const float4 w04 = *(const float4*)(p.w0 + d * 512 + ch);
      const float4 a04 = *(const float4*)(p.a0 + d * 512 + ch);
      const float w0v[4] = {w04.x, w04.y, w04.z, w04.w};
      const float a0v[4] = {a04.x, a04.y, a04.z, a04.w};
      float wd[4], kd[4], bb[4];
#pragma unroll
      for (int i = 0; i < 4; ++i) {
        float sg = sigmoid_f(zw[i] + w0v[i]);
        wd[i] = __expf(-0.6065306597126334f * sg);
        float av = sigmoid_f(za[i] + a0v[i]);
        kd[i] = kp[i] * (1.f + (av - 1.f) * kav[i]);
        bb[i] = kk[i] * av;
        bon += rp[i] * kd[i] * rkv[i];
      }
      u16* pd = ops_d + d * 192;
      *(uint2*)(pd + c) = make_uint2(pack2h(wd[0], wd[1]), pack2h(wd[2], wd[3]));
      *(uint2*)(pd + 64 + c) = pack4bf(kd[0], kd[1], kd[2], kd[3]);
      *(uint2*)(pd + 128 + c) = pack4bf(bb[0], bb[1], bb[2], bb[3]);
    }
  }
  bon += __shfl_xor(bon, 16);
  bon += __shfl_xor(bon, 32);
  if (q == 0) ((float*)(p.ws + OFF_BONUS))[(size_t)m * 8 + h] = bon;
}

DEVINL void fnet_tile(const Params& p, bool latn, int u, char* lds) {
  const int tid = tid_opaque(), lane = tid & 63, w = tid >> 6;
  const u16* proj = (const u16*)(p.ws + OFF_PROJ);
  u16* mixed = (u16*)(p.ws + OFF_H);
  {
      int p0, q0; size_t mbase; float scale;
      f32x4 acc[4][4];
      if (latn) {
        p0 = (u & 7) * 128; q0 = (u >> 3) * 128;
        scale = 0.002762135864009951f;
        mbase = NCTX + (size_t)(p0 >> 9) * 2048 + q0;
        gemm_core((const u16*)(p.ws + OFF_GTL) + (size_t)p0 * 64, (size_t)1024 * 128, (const u16*)(p.ws + OFF_A2048) + (size_t)q0 * 64, (size_t)2048 * 128, 64, lds, acc);
      } else {
        const int v0 = u;
        p0 = (v0 >> 1) * 128; q0 = (v0 & 1) * 128;
        scale = 0.0078125f;
        mbase = (size_t)(p0 >> 9) * 256 + q0;
        gemm_core((const u16*)(p.ws + OFF_GTC) + (size_t)p0 * 64, (size_t)16384 * 128, (const u16*)(p.ws + OFF_A256) + (size_t)q0 * 64, (size_t)256 * 128, 8, lds, acc);
      }
      const int wp = w >> 1, wq = w & 1, fr = lane & 15, fq = lane >> 4;
      const int gc0 = (p0 & 511) + 64 * wp + 4 * fq;
      const size_t m0 = mbase + 64 * wq + fr;
      uint2 gf[4][4];
      float4 b4[4];
#pragma unroll
      for (int i = 0; i < 4; ++i) {
        b4[i] = *(const float4*)(p.b_fnet + gc0 + 16 * i);
#pragma unroll
        for (int j = 0; j < 4; ++j) gf[i][j] = *(const uint2*)(proj + (m0 + 16 * j) * NPROJ + 2176 + gc0 + 16 * i);
      }
#pragma unroll
      for (int i = 0; i < 4; ++i)
#pragma unroll
        for (int j = 0; j < 4; ++j) {
          const f32x4 v = acc[i][j];
          float o0 = (v[0] * scale + b4[i].x) * silu_f(bflo(gf[i][j].x));
          float o1 = (v[1] * scale + b4[i].y) * silu_f(bfhi(gf[i][j].x));
          float o2 = (v[2] * scale + b4[i].z) * silu_f(bflo(gf[i][j].y));
          float o3 = (v[3] * scale + b4[i].w) * silu_f(bfhi(gf[i][j].y));
          *(uint2*)(mixed + kb_off(NTOK, (int)(m0 + 16 * j), 512 + gc0 + 16 * i)) = pack4bf(o0, o1, o2, o3);
        }
  }
}

DEVINL int next_unit(int* counter, char* lds) {
  volatile int* slot = (volatile int*)(lds + 65536);
  __syncthreads();
  if (threadIdx.x == 0) *slot = atomicAdd(counter, 1);
  __syncthreads();
  return *slot;
}

__device__ void phase3_latent(const Params& p) {
  const int tid = tid_opaque(), lane = tid & 63, w = tid >> 6;
  for (int it = blockIdx.x * 4 + w; it < 2048; it += gridDim.x * 4) prep_item(p, 4096 + it, lane);
}

struct StepOps { f32x4 kk, r, w, kd, b; float v; };
DEVINL StepOps load_ops(const float* L, int j, int row) {
  StepOps o;
  o.kk = *(const f32x4*)(L + 4 * j);
  o.r = *(const f32x4*)(L + 64 + 4 * j);
  o.v = L[128 + row];
  o.w = *(const f32x4*)(L + 192 + 4 * j);
  o.kd = *(const f32x4*)(L + 256 + 4 * j);
  o.b = *(const f32x4*)(L + 320 + 4 * j);
  return o;
}
template <int DIR>
DEVINL void scan_unit(const Params& p, int T, int tokbase, int b, int h, int qq, bool ctx, char* lds) {
  constexpr int d = DIR;
  const int tid = tid_opaque(), lane = tid & 63, w = tid >> 6;
  const int g = lane >> 4, j = lane & 15;
  const int row = qq * 16 + w * 4 + g;
  float S0 = 0.f, S1 = 0.f, S2 = 0.f, S3 = 0.f;
  if (!ctx) {
    const float* s0 = (d ? p.st_b : p.st_f) + ((size_t)(b * 8 + h) * 64 + row) * 64 + 4 * j;
    f32x4 s4 = *(const f32x4*)s0;
    S0 = s4[0]; S1 = s4[1]; S2 = s4[2]; S3 = s4[3];
  }
  const u16* ops_s = (const u16*)(p.ws + OFF_OPS_S);
  const u16* ops_d = (const u16*)(p.ws + OFF_OPS_D);
  float* ldsf = (float*)lds;
  u16* yout = ybuf_ptr(p, d, (size_t)tokbase) + h * 64 + row;
  const int nchunks = T >> 4;
  int ps[3], pw[3];
#pragma unroll
  for (int i = 0; i < 3; ++i) { int pi = tid + 256 * i; ps[i] = pi / 48; pw[i] = pi % 48; }
  uint4 rg0[3], rg1[3], rg2[3], rg3[3];
  const char* gp[3];
  int gst[3];
#pragma unroll
  for (int i = 0; i < 3; ++i) {
    const size_t tok = (size_t)(tokbase + (d ? T - 16 : 0) + ps[i]);
    const u16* src = pw[i] < 24 ? ops_s + (tok * 8 + h) * 192 + pw[i] * 8
                                : ops_d + ((tok * 8 + h) * 2 + d) * 192 + (pw[i] - 24) * 8;
    gp[i] = (const char*)src;
    gst[i] = (pw[i] < 24 ? 16 * 8 * 192 * 2 : 16 * 8 * 2 * 192 * 2) * (d ? -1 : 1);
  }
  auto gload = [&](int c, uint4 (&r)[3]) __attribute__((always_inline)) {
    (void)c;
#pragma unroll
    for (int i = 0; i < 3; ++i) { r[i] = *(const uint4*)gp[i]; gp[i] += gst[i]; }
  };
  auto lstore = [&](int buf, const uint4 (&r)[3]) __attribute__((always_inline)) {
#pragma unroll
    for (int i = 0; i < 3; ++i) {
      float* dst = ldsf + buf * 6144 + ps[i] * 384 + pw[i] * 8;
      float4 a, bq;
      if (pw[i] >= 24 && pw[i] < 32) {
        a = make_float4(hlo(r[i].x), hhi(r[i].x), hlo(r[i].y), hhi(r[i].y));
        bq = make_float4(hlo(r[i].z), hhi(r[i].z), hlo(r[i].w), hhi(r[i].w));
      } else {
        a = make_float4(bflo(r[i].x), bfhi(r[i].x), bflo(r[i].y), bfhi(r[i].y));
        bq = make_float4(bflo(r[i].z), bfhi(r[i].z), bflo(r[i].w), bfhi(r[i].w));
      }
      *(float4*)dst = a;
      *(float4*)(dst + 4) = bq;
    }
  };
  gload(0, rg0);
  gload(1, rg1);
  gload(2, rg2);
  lstore(0, rg0);
  __syncthreads();
  auto chunk = [&](const int c, const int cc, uint4 (&ldset)[3], const uint4 (&stset)[3]) __attribute__((always_inline)) {
    {
      if (c + 3 < nchunks) gload(c + 3, ldset);
      const float* L0 = ldsf + (cc & 1) * 6144;
      const int t0 = d ? T - 16 * (c + 1) : 16 * c;
      StepOps ring[3];
      ring[0] = load_ops(L0 + (d ? 15 : 0) * 384, j, row);
      ring[1] = load_ops(L0 + (d ? 14 : 1) * 384, j, row);
      float ykeep = 0.f;
#pragma unroll
      for (int s = 0; s < 16; ++s) {
        const int li = d ? 15 - s : s;
        if (s + 2 < 16) ring[(s + 2) % 3] = load_ops(L0 + (d ? 13 - s : s + 2) * 384, j, row);
        __builtin_amdgcn_sched_barrier(0);
        const StepOps& cur = ring[s % 3];
        float ua = amul(S0, cur.kk[0]);
        float ub = amul(S2, cur.kk[2]);
        ua = afma(S1, cur.kk[1], ua);
        ub = afma(S3, cur.kk[3], ub);
        const float u = allreduce16(ua + ub);
        float t0 = amul(cur.v, cur.kd[0]), t1 = amul(cur.v, cur.kd[1]), t2 = amul(cur.v, cur.kd[2]), t3 = amul(cur.v, cur.kd[3]);
        t0 = afnma(u, cur.b[0], t0); t1 = afnma(u, cur.b[1], t1); t2 = afnma(u, cur.b[2], t2); t3 = afnma(u, cur.b[3], t3);
        S0 = afma(S0, cur.w[0], t0); S1 = afma(S1, cur.w[1], t1); S2 = afma(S2, cur.w[2], t2); S3 = afma(S3, cur.w[3], t3);
        float ya = amul(S0, cur.r[0]);
        float yb = amul(S2, cur.r[2]);
        ya = afma(S1, cur.r[1], ya);
        yb = afma(S3, cur.r[3], yb);
        const float y = allreduce16(ya + yb);
        ykeep = (j == li) ? y : ykeep;
        __builtin_amdgcn_sched_barrier(0);
      }
      yout[(size_t)(t0 + j) * 512] = f2bf(ykeep);
      if (c + 1 < nchunks) lstore((cc + 1) & 1, stset);
      __syncthreads();
    }
  };
  for (int c4 = 0; c4 < nchunks; c4 += 4) {
    chunk(c4 + 0, 0, rg3, rg1);
    chunk(c4 + 1, 1, rg0, rg2);
    chunk(c4 + 2, 2, rg1, rg3);
    chunk(c4 + 3, 3, rg2, rg0);
  }
  if (ctx) {
    float* so = p.out + (d ? 13631488 : 12582912) + ((size_t)(b * 8 + h) * 64 + row) * 64 + 4 * j;
    *(f32x4*)so = (f32x4){S0, S1, S2, S3};
  }
}
constexpr int MS_STEP = 896, MS_BUF = 16 * MS_STEP, MS_ZERO = 2 * MS_BUF;
template <int DIR>
DEVINL void scan_unit_mfma(const Params& p, int T, int tokbase, int b, int h, bool ctx, char* lds) {
  constexpr int d = DIR;
  const int tid = tid_opaque(), lane = tid & 63, wv = tid >> 6;
  const int vr = lane & 15, q = lane >> 4;
  const int row = wv * 16 + vr;
  f32x4 S[4];
#pragma unroll
  for (int kt = 0; kt < 4; ++kt) S[kt] = (f32x4){0.f, 0.f, 0.f, 0.f};
  if (!ctx) {
    const float* s0 = (d ? p.st_b : p.st_f) + ((size_t)(b * 8 + h) * 64 + row) * 64 + 4 * q;
#pragma unroll
    for (int kt = 0; kt < 4; ++kt) S[kt] = *(const f32x4*)(s0 + 16 * kt);
  }
  const u16* ops_s = (const u16*)(p.ws + OFF_OPS_S);
  const u16* ops_d = (const u16*)(p.ws + OFF_OPS_D);
  u16* ybase = ybuf_ptr(p, d, (size_t)tokbase) + h * 64 + row;
  const int nchunks = T >> 4;
  if (tid < 16) *(uint4*)(lds + MS_ZERO + tid * 16) = make_uint4(0u, 0u, 0u, 0u);
  int fs[3], fw[3];
#pragma unroll
  for (int i = 0; i < 3; ++i) { int idx = tid + 256 * i; fs[i] = idx / 48; fw[i] = idx % 48; }
  uint4 ra[3];
  const char* gp[3];
  int gst[3];
#pragma unroll
  for (int i = 0; i < 3; ++i) {
    const size_t tok = (size_t)(tokbase + (d ? T - 16 : 0) + fs[i]);
    const u16* src = fw[i] < 24 ? ops_s + (tok * 8 + h) * 192 + fw[i] * 8
                                : ops_d + ((tok * 8 + h) * 2 + d) * 192 + (fw[i] - 24) * 8;
    gp[i] = (const char*)src;
    gst[i] = (fw[i] < 24 ? 16 * 8 * 192 * 2 : 16 * 8 * 2 * 192 * 2) * (d ? -1 : 1);
  }
  auto gload = [&](int c) __attribute__((always_inline)) {
    (void)c;
#pragma unroll
    for (int i = 0; i < 3; ++i) { ra[i] = *(const uint4*)gp[i]; gp[i] += gst[i]; }
  };
  auto lstore = [&](int buf) __attribute__((always_inline)) {
#pragma unroll
    for (int i = 0; i < 3; ++i) {
      char* st = lds + buf * MS_BUF + fs[i] * MS_STEP;
      const int ty = fw[i] >> 3, c = fw[i] & 7;
      if (ty < 2) {
        const int hi4 = ((c >> 1) & 1) * 4;
        const int p1 = ((c >> 2) * 4 + ((2 * c) & 3)) * 8 + hi4;
        const int p2 = ((c >> 2) * 4 + ((2 * c + 1) & 3)) * 8 + hi4;
        char* base = st + ty * 128;
        *(uint2*)(base + p1 * 2) = make_uint2(ra[i].x, ra[i].y);
        *(uint2*)(base + p2 * 2) = make_uint2(ra[i].z, ra[i].w);
      } else if (ty == 2) {
        *(uint4*)(st + 256 + c * 16) = ra[i];
      } else if (ty == 3) {
        float* wdst = (float*)(st + 640) + c * 8;
        *(float4*)wdst = make_float4(hlo(ra[i].x), hhi(ra[i].x), hlo(ra[i].y), hhi(ra[i].y));
        *(float4*)(wdst + 4) = make_float4(hlo(ra[i].z), hhi(ra[i].z), hlo(ra[i].w), hhi(ra[i].w));
      } else {
        const uint32_t flip = (ty == 5) ? 0x80008000u : 0u;
        u16* kdst = (u16*)(st + 384) + c * 16 + (ty == 5 ? 1 : 0);
        const uint32_t x0 = ra[i].x ^ flip, x1 = ra[i].y ^ flip, x2 = ra[i].z ^ flip, x3 = ra[i].w ^ flip;
        kdst[0] = (u16)(x0 & 0xFFFFu);  kdst[2] = (u16)(x0 >> 16);
        kdst[4] = (u16)(x1 & 0xFFFFu);  kdst[6] = (u16)(x1 >> 16);
        kdst[8] = (u16)(x2 & 0xFFFFu);  kdst[10] = (u16)(x2 >> 16);
        kdst[12] = (u16)(x3 & 0xFFFFu); kdst[14] = (u16)(x3 >> 16);
      }
    }
  };
  gload(0);
  lstore(0);
  __syncthreads();
  const int sel = lane & 3;
  const unsigned fragoff = (unsigned)q * 16u;
  const unsigned qmask = (q == 0) ? 0xFFFFFFFFu : 0u;
  const char* rprev = lds + MS_ZERO;
  float yk[4] = {0.f, 0.f, 0.f, 0.f};
  auto yflush = [&](int tprev0) {
#pragma unroll
    for (int a = 0; a < 4; ++a) ybase[(size_t)(tprev0 + 4 * a + q) * 512] = f2bf(yk[a]);
  };
  struct MOps { bf16x8 a0, a1; unsigned vv; uint32_t kdb[4]; };
  const bool sel0 = sel == 0, sel1 = sel == 1;
  auto mload = [&](const char* L, const char* rp) __attribute__((always_inline)) {
    MOps o;
    const unsigned offL = (unsigned)(L - lds) + fragoff, offR = (unsigned)(rp - lds) + 128u + fragoff;
    const unsigned aoff = sel0 ? offL : (sel1 ? offR : (unsigned)MS_ZERO);
    const char* aptr = lds + aoff;
    o.a0 = *(const bf16x8*)aptr;
    o.a1 = *(const bf16x8*)(aptr + 64);
    o.vv = *(const u16*)(L + 256 + row * 2);
#pragma unroll
    for (int kt = 0; kt < 4; ++kt) {
      o.kdb[kt] = *(const uint32_t*)(L + 384 + (16 * kt + vr) * 4);
    }
    return o;
  };
  for (int c = 0; c < nchunks; ++c) {
    const bool more = c + 1 < nchunks;
    if (more) gload(c + 1);
    const char* L0 = lds + (c & 1) * MS_BUF;
    MOps ring[2];
    ring[0] = mload(L0 + (d ? 15 : 0) * MS_STEP, rprev);
#pragma unroll
    for (int s = 0; s < 16; ++s) {
      const int li = d ? 15 - s : s;
      const char* L = L0 + li * MS_STEP;
      if (s < 15) ring[(s + 1) & 1] = mload(L0 + (d ? 14 - s : s + 1) * MS_STEP, L);
      f32x4 w4[4];
#pragma unroll
      for (int kt = 0; kt < 4; ++kt) w4[kt] = *(const f32x4*)(L + 640 + (16 * kt + 4 * q) * 4);
      __builtin_amdgcn_sched_barrier(0);
      const MOps& cur = ring[s & 1];
      uint4 pb0 = make_uint4(pack2bf(S[0][0], S[0][1]), pack2bf(S[0][2], S[0][3]), pack2bf(S[1][0], S[1][1]), pack2bf(S[1][2], S[1][3]));
      uint4 pb1 = make_uint4(pack2bf(S[2][0], S[2][1]), pack2bf(S[2][2], S[2][3]), pack2bf(S[3][0], S[3][1]), pack2bf(S[3][2], S[3][3]));
      f32x4 D = {0.f, 0.f, 0.f, 0.f};
      D = __builtin_amdgcn_mfma_f32_16x16x32_bf16(cur.a0, __builtin_bit_cast(bf16x8, pb0), D, 0, 0, 0);
      D = __builtin_amdgcn_mfma_f32_16x16x32_bf16(cur.a1, __builtin_bit_cast(bf16x8, pb1), D, 0, 0, 0);
      const float u = D[0], yprev = D[1];
      {
        const int pi = (s == 0) ? (d ? 0 : 15) : (d ? 16 - s : s - 1);
        yk[pi >> 2] = (q == (pi & 3)) ? yprev : yk[pi >> 2];
        if (s == 0 && c > 0) yflush(d ? T - 16 * c : 16 * (c - 1));
      }
      const uint32_t b3w = (cur.vv | (pack2bf(u, 0.f) << 16)) & qmask;
      const uint4 b3v = make_uint4(b3w, 0u, 0u, 0u);
      const bf16x8 B3 = __builtin_bit_cast(bf16x8, b3v);
#pragma unroll
      for (int kt = 0; kt < 4; ++kt) {
        const uint4 a3v = make_uint4(cur.kdb[kt] & qmask, 0u, 0u, 0u);
        const f32x4 C = S[kt] * w4[kt];
        S[kt] = __builtin_amdgcn_mfma_f32_16x16x32_bf16(__builtin_bit_cast(bf16x8, a3v), B3, C, 0, 0, 0);
      }
      rprev = L;
      __builtin_amdgcn_sched_barrier(0);
    }
    if (more) lstore((c + 1) & 1);
    __syncthreads();
  }
  {
    const char* aptr = (sel == 1) ? rprev + 128 + fragoff : lds + MS_ZERO;
    const bf16x8 a0 = *(const bf16x8*)aptr;
    const bf16x8 a1 = *(const bf16x8*)(aptr + 64);
    uint4 pb0 = make_uint4(pack2bf(S[0][0], S[0][1]), pack2bf(S[0][2], S[0][3]), pack2bf(S[1][0], S[1][1]), pack2bf(S[1][2], S[1][3]));
    uint4 pb1 = make_uint4(pack2bf(S[2][0], S[2][1]), pack2bf(S[2][2], S[2][3]), pack2bf(S[3][0], S[3][1]), pack2bf(S[3][2], S[3][3]));
    f32x4 D = {0.f, 0.f, 0.f, 0.f};
    D = __builtin_amdgcn_mfma_f32_16x16x32_bf16(a0, __builtin_bit_cast(bf16x8, pb0), D, 0, 0, 0);
    D = __builtin_amdgcn_mfma_f32_16x16x32_bf16(a1, __builtin_bit_cast(bf16x8, pb1), D, 0, 0, 0);
    const int pi = d ? 0 : 15;
    yk[pi >> 2] = (q == (pi & 3)) ? D[1] : yk[pi >> 2];
    yflush(d ? 0 : T - 16);
  }
  if (ctx) {
    float* so = p.out + (d ? 13631488 : 12582912) + ((size_t)(b * 8 + h) * 64 + row) * 64 + 4 * q;
#pragma unroll
    for (int kt = 0; kt < 4; ++kt) *(f32x4*)(so + 16 * kt) = S[kt];
  }
  __syncthreads();
}

DEVINL void scan_dispatch(const Params& p, int unit, char* lds) {
  int T, tokbase, b, h, d, qq;
  bool ctx;
  if (unit < 128) { qq = unit & 3; d = (unit >> 2) & 1; h = (unit >> 3) & 7; b = unit >> 6; T = 2048; tokbase = NCTX + b * 2048; ctx = false; }
  else { const int u = unit - 128; qq = u & 3; d = (u >> 2) & 1; h = (u >> 3) & 7; b = u >> 6; T = 256; tokbase = b * 256; ctx = true; }
  if (!ctx) __builtin_amdgcn_s_setprio(3);
  if (d) scan_unit<1>(p, T, tokbase, b, h, qq, ctx, lds);
  else scan_unit<0>(p, T, tokbase, b, h, qq, ctx, lds);
  if (!ctx) __builtin_amdgcn_s_setprio(0);
}

DEVINL void scan_dispatch_mfma(const Params& p, int unit, char* lds) {
  const bool ctx = unit >= 32;
  const int u = ctx ? unit - 32 : unit;
  const int d = u & 1, h = (u >> 1) & 7, b = u >> 4;
  const int T = ctx ? 256 : 2048;
  const int tokbase = ctx ? b * 256 : NCTX + b * 2048;
  if (d) scan_unit_mfma<1>(p, T, tokbase, b, h, ctx, lds);
  else scan_unit_mfma<0>(p, T, tokbase, b, h, ctx, lds);
}

DEVINL void post_item(const Params& p, int item, int lane) {
  const int r = lane & 15, q = lane >> 4;
  const u16* proj = (const u16*)(p.ws + OFF_PROJ);
  const u16* ops_s = (const u16*)(p.ws + OFF_OPS_S);
  const float* bonus = (const float*)(p.ws + OFF_BONUS);
  u16* mixed = (u16*)(p.ws + OFF_H);
  {
    const int tile = item >> 3, h = item & 7;
    const size_t m = (size_t)tile * 16 + r;
    float y[16];
    float sum = 0.f;
#pragma unroll
    for (int mt = 0; mt < 4; ++mt) {
      const int ch = h * 64 + 16 * mt + 4 * q;
      uint2 ya = *(const uint2*)(ybuf_ptr(p, 0, m) + ch);
      uint2 yb = *(const uint2*)(ybuf_ptr(p, 1, m) + ch);
      y[4 * mt + 0] = bflo(ya.x) + bflo(yb.x); y[4 * mt + 1] = bfhi(ya.x) + bfhi(yb.x); y[4 * mt + 2] = bflo(ya.y) + bflo(yb.y); y[4 * mt + 3] = bfhi(ya.y) + bfhi(yb.y);
      sum += y[4 * mt] + y[4 * mt + 1] + y[4 * mt + 2] + y[4 * mt + 3];
    }
    sum += __shfl_xor(sum, 16);
    sum += __shfl_xor(sum, 32);
    const float mean = sum * (1.f / 64.f);
    float var = 0.f;
#pragma unroll
    for (int i = 0; i < 16; ++i) { float dlt = y[i] - mean; var += dlt * dlt; }
    var += __shfl_xor(var, 16);
    var += __shfl_xor(var, 32);
    const float rstd = rsqrtf(var * (1.f / 64.f) + 64e-5f);
    const float bon = bonus[m * 8 + h];
#pragma unroll
    for (int mt = 0; mt < 4; ++mt) {
      const int c = 16 * mt + 4 * q, ch = h * 64 + c;
      float4 gg = *(const float4*)(p.gn_g + ch);
      float4 gb = *(const float4*)(p.gn_b + ch);
      uint2 vv = *(const uint2*)(ops_s + (m * 8 + h) * 192 + 128 + c);
      uint2 gr = *(const uint2*)(proj + m * NPROJ + 1664 + ch);
      float o0 = ((y[4 * mt + 0] - mean) * rstd * gg.x + gb.x + bon * bflo(vv.x)) * silu_f(bflo(gr.x));
      float o1 = ((y[4 * mt + 1] - mean) * rstd * gg.y + gb.y + bon * bfhi(vv.x)) * silu_f(bfhi(gr.x));
      float o2 = ((y[4 * mt + 2] - mean) * rstd * gg.z + gb.z + bon * bflo(vv.y)) * silu_f(bflo(gr.y));
      float o3 = ((y[4 * mt + 3] - mean) * rstd * gg.w + gb.w + bon * bfhi(vv.y)) * silu_f(bfhi(gr.y));
      *(uint2*)(mixed + kb_off(NTOK, (int)m, ch)) = pack4bf(o0, o1, o2, o3);
    }
  }
}
__device__ void phase5_latent(const Params& p) {
  const int tid = tid_opaque(), lane = tid & 63, w = tid >> 6;
  for (int it = blockIdx.x * 4 + w; it < 2048; it += gridDim.x * 4) post_item(p, 4096 + it, lane);
}

DEVINL void outproj_tile(const Params& p, int id, char* lds) {
  const u16* wot = (const u16*)(p.ws + OFF_WOT);
  const u16* mixed = (const u16*)(p.ws + OFF_H);
  const float* mod = (const float*)(p.ws + OFF_MOD);
  const float* rowtab = (const float*)(p.ws + OFF_ROWTAB);
  const float* coltab = (const float*)(p.ws + OFF_COLTAB);
  const float* xp = p.x_prompt; const float* xs = p.x_sample;
  float* out = p.out;
  {
    const int mg = id >> 6, rem = id & 63;
    const int nt = rem >> 3, mt = mg * 8 + (rem & 7);
    const int n0 = nt * 128, m0 = mt * 128;
    f32x4 acc[4][4];
    gemm_core(wot + (size_t)n0 * 64, (size_t)1024 * 128, mixed + (size_t)m0 * 64, (size_t)NTOK * 128, 16, lds, acc);
    const int tid = tid_opaque(), lane = tid & 63, w = tid >> 6, wp = w >> 1, wq = w & 1, fr = lane & 15, fq = lane >> 4;
    const bool lat = m0 >= NCTX;
    const int mi = lat ? 1 + ((m0 - NCTX) >> 11) : 0;
    const int nb = n0 + 64 * wp + 4 * fq;
    const int mb = m0 + 64 * wq + fr;
    float4 g4[4];
#pragma unroll
    for (int i = 0; i < 4; ++i) g4[i] = *(const float4*)(mod + mi * 3072 + 2048 + nb + 16 * i);
#pragma unroll
    for (int jh = 0; jh < 2; ++jh) {
      float4 x4[4][2], e4[4][2];
#pragma unroll
      for (int i = 0; i < 4; ++i)
#pragma unroll
        for (int jj = 0; jj < 2; ++jj) {
          const int m = mb + 16 * (2 * jh + jj), n = nb + 16 * i;
          if (!lat) {
            x4[i][jj] = *(const float4*)(xp + (size_t)m * 1024 + n);
            e4[i][jj] = make_float4(0.f, 0.f, 0.f, 0.f);
          } else {
            const int mp = m - NCTX, t = mp & 2047;
            x4[i][jj] = *(const float4*)(xs + (size_t)mp * 1024 + n);
            const float* e = n < 512 ? rowtab + (t >> 6) * 512 + n : coltab + (t & 63) * 512 + (n - 512);
            e4[i][jj] = *(const float4*)e;
          }
        }
#pragma unroll
      for (int i = 0; i < 4; ++i)
#pragma unroll
        for (int jj = 0; jj < 2; ++jj) {
          const int m = mb + 16 * (2 * jh + jj), n = nb + 16 * i;
          const f32x4 v = acc[i][2 * jh + jj];
          float4 o = make_float4(x4[i][jj].x + e4[i][jj].x + g4[i].x * v[0], x4[i][jj].y + e4[i][jj].y + g4[i].y * v[1],
                                 x4[i][jj].z + e4[i][jj].z + g4[i].z * v[2], x4[i][jj].w + e4[i][jj].w + g4[i].w * v[3]);
          *(float4*)(out + (size_t)m * 1024 + n) = o;
        }
    }
  }
}
__device__ void phase6_latent(const Params& p, char* lds) {
  constexpr int ID0 = 512, NTILES = 256;
  int first, step, last;
  if ((gridDim.x & 7) == 0) { const int per = NTILES / 8, x = blockIdx.x & 7; first = x * per + (blockIdx.x >> 3); step = gridDim.x >> 3; last = (x + 1) * per; }
  else { first = blockIdx.x; step = gridDim.x; last = NTILES; }
  for (int id = first; id < last; id += step) outproj_tile(p, ID0 + id, lds);
}

DEVINL void final_row2(const Params& p, int m, int lane) {
  float* rowp = p.out + (size_t)m * 1024;
  float4 v[2][4];
  float ss0 = 0.f, ss1 = 0.f;
#pragma unroll
  for (int i = 0; i < 4; ++i) {
    v[0][i] = *(const float4*)(rowp + lane * 4 + 256 * i);
    v[1][i] = *(const float4*)(rowp + 1024 + lane * 4 + 256 * i);
  }
#pragma unroll
  for (int i = 0; i < 4; ++i) {
    ss0 += v[0][i].x * v[0][i].x + v[0][i].y * v[0][i].y + v[0][i].z * v[0][i].z + v[0][i].w * v[0][i].w;
    ss1 += v[1][i].x * v[1][i].x + v[1][i].y * v[1][i].y + v[1][i].z * v[1][i].z + v[1][i].w * v[1][i].w;
  }
  ss0 = wave_sum(ss0);
  ss1 = wave_sum(ss1);
  const float r0 = rsqrtf(ss0 * (1.f / 1024.f) + 1e-6f), r1 = rsqrtf(ss1 * (1.f / 1024.f) + 1e-6f);
#pragma unroll
  for (int i = 0; i < 4; ++i) {
    float4 g4 = *(const float4*)(p.fng + lane * 4 + 256 * i);
    *(float4*)(rowp + lane * 4 + 256 * i) = make_float4(v[0][i].x * r0 * g4.x, v[0][i].y * r0 * g4.y, v[0][i].z * r0 * g4.z, v[0][i].w * r0 * g4.w);
    *(float4*)(rowp + 1024 + lane * 4 + 256 * i) = make_float4(v[1][i].x * r1 * g4.x, v[1][i].y * r1 * g4.y, v[1][i].z * r1 * g4.z, v[1][i].w * r1 * g4.w);
  }
}
__device__ void phase7_latent(const Params& p) {
  const int tid = tid_opaque(), lane = tid & 63, w = tid >> 6;
  for (int m = NCTX + (blockIdx.x * 4 + w) * 2; m < NTOK; m += gridDim.x * 8) final_row2(p, m, lane);
}

__device__ void phase4(const Params& p, char* lds) {
  const int tid = tid_opaque(), lane = tid & 63, w = tid >> 6;
  int* cnt = (int*)(p.ws + OFF_CNT);
  int role;
  if (gridDim.x == 512) {
    const int x = blockIdx.x & 7, i = blockIdx.x >> 3;
    const bool lat = i < 32 ? ((i & 3) == 0) : ((i & 3) == 2);
    role = lat ? x * 16 + (i >> 2) : (1 << 20);
  } else {
    role = next_unit(cnt + 1, lds);
  }
  if (role < 128) {
    scan_dispatch(p, role, lds);
  } else {
  XcdBarrier wb = xcd_barrier_post((unsigned*)(p.ws + OFF_BAR2), (volatile LAS unsigned*)(lds + 65536 + 32), gridDim.x - 128);
  int nst = 5;
  asm volatile("" : "+s"(nst));
  for (int stage = 0; stage < nst; ++stage) {
    const int nunits = stage == 0 ? 256 + 1024 : stage == 1 ? 512 + 128 : stage == 2 ? 1024 : 512;
    for (;;) {
      const int u = next_unit(cnt + 2 + stage, lds);
      if (u >= nunits) break;
      if (stage == 0) { if (u < 256) fnet_tile(p, false, u, lds); else prep_item(p, (u - 256) * 4 + w, lane); }
      else if (stage == 1) { if (u < 512) scan_dispatch_mfma(p, 32 + u, lds); else fnet_tile(p, true, u - 512, lds); }
      else if (stage == 2) post_item(p, u * 4 + w, lane);
      else if (stage == 3) outproj_tile(p, u, lds);
      else { const int m0 = u * 16 + w * 4; final_row2(p, m0, lane); final_row2(p, m0 + 2, lane); }
    }
    if (stage + 1 < nst) xcd_barrier(wb);
  }
  }
}

__global__ void __launch_bounds__(THREADS, 2) fwd_megakernel(Params p) {
  extern __shared__ __attribute__((aligned(16))) char lds[];
  if (p.use_cg) cg::this_grid().sync();
  if (threadIdx.x == 0) { *(uint4*)(lds + 65536 + 16) = make_uint4(0u, 0u, 0u, 0u); *(uint4*)(lds + 65536 + 32) = make_uint4(0u, 0u, 0u, 0u); }
  __syncthreads();
  XcdBarrier bar = xcd_barrier_post((unsigned*)(p.ws + OFF_BAR), (volatile LAS unsigned*)(lds + 65536 + 16), gridDim.x);
  phase0(p, lds);
  xcd_barrier(bar);
  phase1(p, lds);
  xcd_barrier(bar);
  phase2_all(p, lds);
  xcd_barrier(bar);
  phase3_latent(p);
  xcd_barrier(bar);
  phase4(p, lds);
  xcd_barrier(bar);
  phase5_latent(p);
  xcd_barrier(bar);
  phase6_latent(p, lds);
  xcd_barrier(bar);
  phase7_latent(p);
}

extern "C" void kernel_launch(void* const* d_in, const int* in_sizes, int n_in, void* d_out, int out_size, void* d_ws, size_t ws_size,
                              hipStream_t stream) {
  static int grid_blocks = 0;
  if (grid_blocks == 0) {
    if (n_in != 24 || ws_size < WS_NEED) {
      fprintf(stderr, "kernel_launch: need 24 inputs and >= %zu bytes of workspace (got %d, %zu)\n", (size_t)WS_NEED, n_in, ws_size);
      grid_blocks = -1;
      return;
    }
    int dev = 0, cus = 0, per_cu = 0;
    hipGetDevice(&dev);
    hipDeviceGetAttribute(&cus, hipDeviceAttributeMultiprocessorCount, dev);
    if (hipFuncSetAttribute((const void*)fwd_megakernel, hipFuncAttributeMaxDynamicSharedMemorySize, LDS_BYTES) != hipSuccess) {
      fprintf(stderr, "kernel_launch: hipFuncSetAttribute failed\n");
      grid_blocks = -1;
      return;
    }
    hipOccupancyMaxActiveBlocksPerMultiprocessor(&per_cu, (const void*)fwd_megakernel, THREADS, LDS_BYTES);
    if (per_cu < 1) { fprintf(stderr, "kernel_launch: occupancy query returned %d\n", per_cu); grid_blocks = -1; return; }
    if (per_cu > 2) per_cu = 2;
    grid_blocks = cus * per_cu;
  }
  if (grid_blocks < 0) return;
  hipMemsetAsync(d_ws, 0, ZERO_BYTES, stream);
  Params p{};
  const float* const* in = (const float* const*)d_in;
  p.x_prompt = in[0]; p.x_sample = in[1]; p.st_f = in[2]; p.st_b = in[3]; p.c = in[4]; p.c_ctx = in[5]; p.w_ada = in[6]; p.b_ada = in[7];
  p.norm_g = in[8]; p.w_in = in[9]; p.mu = in[10]; p.w0 = in[11]; p.w2 = in[12]; p.a0 = in[13]; p.a2 = in[14]; p.k_k = in[15]; p.k_a = in[16];
  p.r_k = in[17]; p.gn_g = in[18]; p.gn_b = in[19]; p.w_fnet = in[20]; p.b_fnet = in[21]; p.w_out = in[22]; p.fng = in[23];
  p.out = (float*)d_out;
  p.ws = (char*)d_ws;
  void* args[] = {&p};
  hipError_t e = hipLaunchCooperativeKernel((const void*)fwd_megakernel, dim3(grid_blocks), dim3(THREADS), args, LDS_BYTES, stream);
  if (e != hipSuccess) fprintf(stderr, "cooperative launch failed: %s (grid %d)\n", hipGetErrorString(e), grid_blocks);
}
```
